# Optimizing an MI355X kernel written in HIP

```python
import jax, jax.numpy as jnp
from jax import lax
import numpy as np

D_MODEL = 1024
BATCH = 4
SEQ = 4096
DEPTH = 4

HEAD_DIM = 64
N_FOX = 6
N_DSA = 5
N_SB = 5
N_IDX_HEADS = 8
IDX_DIM = 64
TOPK_MAX = 256
N_MEM = 256
N_CA_HEADS = 4
CA_HEAD_DIM = 128
D_FF = 2816
ROPE_THETA = 10000.0
Q_BLOCK = 128
NORM_EPS = 1e-6
N_BRANCH = 3
HALF_STEP = 0.5
FGATE_BIAS_OFFSET = 3.0

FOX_W = N_FOX * HEAD_DIM
DSA_W = N_DSA * HEAD_DIM
SB_W = N_SB * HEAD_DIM
CA_W = N_CA_HEADS * CA_HEAD_DIM
IN_SPLITS = (3 * FOX_W, N_FOX, 3 * DSA_W, N_IDX_HEADS * IDX_DIM, IDX_DIM, N_IDX_HEADS, 3 * SB_W, N_BRANCH * D_MODEL)
D_IN = 3 * FOX_W + N_FOX + 3 * DSA_W + N_IDX_HEADS * IDX_DIM + IDX_DIM + N_IDX_HEADS + 3 * SB_W + N_BRANCH * D_MODEL

kernel_name = 'hybrid_fox_dsa_stickbreak_macaron_trunk'


def rms_norm(x, g):
    xf = x.astype(jnp.float32)
    y = xf * lax.rsqrt(jnp.mean(xf * xf, axis=-1, keepdims=True) + NORM_EPS) * g.astype(jnp.float32)
    return y.astype(x.dtype)


def apply_rope(x, positions):
    d = x.shape[-1]
    half = d // 2
    inv_freq = jnp.power(ROPE_THETA, -jnp.arange(half, dtype=jnp.float32) * (2.0 / d))
    ang = positions.astype(jnp.float32)[..., None] * inv_freq
    cos = jnp.cos(ang)[:, :, None, :]
    sin = jnp.sin(ang)[:, :, None, :]
    xf = x.astype(jnp.float32)
    x1, x2 = xf[..., :half], xf[..., half:]
    return jnp.concatenate([x1 * cos - x2 * sin, x2 * cos + x1 * sin], axis=-1).astype(x.dtype)


def swiglu(h, w_gu, w_down):
    g, u = jnp.split(h @ w_gu, 2, axis=-1)
    return (jax.nn.silu(g) * u) @ w_down


def sweep_query_blocks(block_fn, seq_len):
    n_blocks = seq_len // Q_BLOCK
    out = lax.map(block_fn, jnp.arange(n_blocks, dtype=jnp.int32) * Q_BLOCK)
    out = jnp.moveaxis(out, 0, 1)
    return out.reshape((out.shape[0], seq_len) + out.shape[3:])


def fox_attention(q, k, v, log_f):
    seq_len, d = q.shape[1], q.shape[-1]
    scale = d ** -0.5
    c = jnp.cumsum(log_f, axis=1).transpose(0, 2, 1)
    key_pos = jnp.arange(seq_len)

    def block(start):
        qb = lax.dynamic_slice_in_dim(q, start, Q_BLOCK, axis=1)
        cb = lax.dynamic_slice_in_dim(c, start, Q_BLOCK, axis=2)
        logits = jnp.einsum('bqhd,bkhd->bhqk', qb, k).astype(jnp.float32) * scale
        logits = logits + cb[..., :, None] - c[:, :, None, :]
        qpos = start + jnp.arange(Q_BLOCK)
        causal = key_pos[None, :] <= qpos[:, None]
        p = jax.nn.softmax(jnp.where(causal, logits, -jnp.inf), axis=-1)
        return jnp.einsum('bhqk,bkhd->bqhd', p.astype(v.dtype), v)

    return sweep_query_blocks(block, seq_len)


def stick_breaking_attention(q, k, v):
    seq_len, d = q.shape[1], q.shape[-1]
    scale = d ** -0.5
    key_pos = jnp.arange(seq_len)

    def block(start):
        qb = lax.dynamic_slice_in_dim(q, start, Q_BLOCK, axis=1)
        z = jnp.einsum('bqhd,bkhd->bhqk', qb, k).astype(jnp.float32) * scale
        qpos = start + jnp.arange(Q_BLOCK)
        strict = key_pos[None, :] < qpos[:, None]
        log_beta = jax.nn.log_sigmoid(z)
        log_1m_beta = jnp.where(strict, jax.nn.log_sigmoid(-z), 0.0)
        after = lax.cumsum(log_1m_beta, axis=3, reverse=True) - log_1m_beta
        a = jnp.where(strict, jnp.exp(log_beta + after), 0.0)
        return jnp.einsum('bhqk,bkhd->bqhd', a.astype(v.dtype), v)

    return sweep_query_blocks(block, seq_len)


def dsa_sparse_attention(q, k, v, q_idx, k_idx, w_idx, topk):
    seq_len, d = q.shape[1], q.shape[-1]
    scale = d ** -0.5
    key_pos = jnp.arange(seq_len)

    def block(start):
        qb = lax.dynamic_slice_in_dim(q, start, Q_BLOCK, axis=1)
        qib = lax.dynamic_slice_in_dim(q_idx, start, Q_BLOCK, axis=1)
        wb = lax.dynamic_slice_in_dim(w_idx, start, Q_BLOCK, axis=1)
        head_scores = jax.nn.relu(jnp.einsum('bqhd,bkd->bqhk', qib, k_idx).astype(jnp.float32))
        score = jnp.einsum('bqhk,bqh->bqk', head_scores, wb)
        qpos = start + jnp.arange(Q_BLOCK)
        causal = key_pos[None, :] <= qpos[:, None]
        score = jnp.where(causal[None], score, -jnp.inf)
        _, idx = lax.top_k(score, topk)
        valid = idx <= qpos[None, :, None]
        gather = jax.vmap(lambda arr, ii: arr[ii])
        k_sel = gather(k, idx)
        v_sel = gather(v, idx)
        logits = jnp.einsum('bqhd,bqkhd->bhqk', qb, k_sel).astype(jnp.float32) * scale
        logits = jnp.where(valid[:, None], logits, -jnp.inf)
        p = jax.nn.softmax(logits, axis=-1)
        return jnp.einsum('bhqk,bqkhd->bqhd', p.astype(v_sel.dtype), v_sel)

    return sweep_query_blocks(block, seq_len)


def hybrid_mixer(h, positions, w_in, b_fgate, w_fox_out, w_dsa_out, w_sb_out, w_out):
    b, s, _ = h.shape
    proj = h @ w_in
    offsets = np.cumsum(np.array(IN_SPLITS))[:-1].tolist()
    fox_qkv, fox_f, dsa_qkv, idx_q, idx_k, idx_w, sb_qkv, gates = jnp.split(proj, offsets, axis=-1)

    fq, fk, fv = [t[:, :, 0] for t in jnp.split(fox_qkv.reshape(b, s, 3, N_FOX, HEAD_DIM), 3, axis=2)]
    log_f = jax.nn.log_sigmoid(fox_f.astype(jnp.float32) + b_fgate.astype(jnp.float32))
    o_fox = fox_attention(fq, fk, fv, log_f).reshape(b, s, FOX_W)

    dq, dk, dv = [t[:, :, 0] for t in jnp.split(dsa_qkv.reshape(b, s, 3, N_DSA, HEAD_DIM), 3, axis=2)]
    dq = apply_rope(dq, positions)
    dk = apply_rope(dk, positions)
    q_idx = apply_rope(idx_q.reshape(b, s, N_IDX_HEADS, IDX_DIM), positions)
    k_idx = apply_rope(idx_k.reshape(b, s, 1, IDX_DIM), positions)[:, :, 0]
    w_idx = idx_w.astype(jnp.float32) * (N_IDX_HEADS ** -0.5) * (IDX_DIM ** -0.5)
    topk = min(TOPK_MAX, s // 4)
    o_dsa = dsa_sparse_attention(dq, dk, dv, q_idx, k_idx, w_idx, topk).reshape(b, s, DSA_W)

    sq, sk, sv = [t[:, :, 0] for t in jnp.split(sb_qkv.reshape(b, s, 3, N_SB, HEAD_DIM), 3, axis=2)]
    o_sb = stick_breaking_attention(sq, sk, sv).reshape(b, s, SB_W)

    g = jax.nn.sigmoid(gates.reshape(b, s, N_BRANCH, D_MODEL))
    merged = g[:, :, 0] * (o_fox @ w_fox_out) + g[:, :, 1] * (o_dsa @ w_dsa_out) + g[:, :, 2] * (o_sb @ w_sb_out)
    return merged @ w_out


def memory_cross_attention(h, mem_n, w_q, w_kv, w_o):
    b, s, _ = h.shape
    q = (h @ w_q).reshape(b, s, N_CA_HEADS, CA_HEAD_DIM)
    k, v = jnp.split((mem_n @ w_kv).reshape(b, mem_n.shape[1], 2, N_CA_HEADS, CA_HEAD_DIM), 2, axis=2)
    k, v = k[:, :, 0], v[:, :, 0]
    logits = jnp.einsum('bshd,bmhd->bhsm', q, k).astype(jnp.float32) * (CA_HEAD_DIM ** -0.5)
    p = jax.nn.softmax(logits, axis=-1)
    o = jnp.einsum('bhsm,bmhd->bshd', p.astype(v.dtype), v).reshape(b, s, CA_W)
    return o @ w_o


def setup_inputs(seed: int = 0) -> dict:
    key = jax.random.key(seed)
    ks = jax.random.split(key, 24)
    f32 = jnp.float32

    def dense(k, shape):
        return jax.random.normal(k, shape, f32) * (shape[-2] ** -0.5)

    def gain(k, shape):
        return 1.0 + 0.02 * jax.random.normal(k, shape, f32)

    return {
        'x': jax.random.normal(ks[0], (BATCH, SEQ, D_MODEL), f32),
        'mem': jax.random.normal(ks[1], (BATCH, N_MEM, D_MODEL), f32),
        'positions': jnp.broadcast_to(jnp.arange(SEQ, dtype=jnp.int32), (BATCH, SEQ)),
        'ffn1_norm': gain(ks[2], (DEPTH, D_MODEL)),
        'ffn1_w_gu': dense(ks[3], (DEPTH, D_MODEL, 2 * D_FF)),
        'ffn1_w_down': dense(ks[4], (DEPTH, D_FF, D_MODEL)),
        'mix_norm': gain(ks[5], (DEPTH, D_MODEL)),
        'w_in': dense(ks[6], (DEPTH, D_MODEL, D_IN)),
        'b_fgate': FGATE_BIAS_OFFSET + 0.1 * jax.random.normal(ks[7], (DEPTH, N_FOX), f32),
        'w_fox_out': dense(ks[8], (DEPTH, FOX_W, D_MODEL)),
        'w_dsa_out': dense(ks[9], (DEPTH, DSA_W, D_MODEL)),
        'w_sb_out': dense(ks[10], (DEPTH, SB_W, D_MODEL)),
        'w_out': dense(ks[11], (DEPTH, D_MODEL, D_MODEL)),
        'ca_norm': gain(ks[12], (DEPTH, D_MODEL)),
        'mem_norm': gain(ks[13], (DEPTH, D_MODEL)),
        'ca_w_q': dense(ks[14], (DEPTH, D_MODEL, CA_W)),
        'ca_w_kv': dense(ks[15], (DEPTH, D_MODEL, 2 * CA_W)),
        'ca_w_o': dense(ks[16], (DEPTH, CA_W, D_MODEL)),
        'ffn2_norm': gain(ks[17], (DEPTH, D_MODEL)),
        'ffn2_w_gu': dense(ks[18], (DEPTH, D_MODEL, 2 * D_FF)),
        'ffn2_w_down': dense(ks[19], (DEPTH, D_FF, D_MODEL)),
        'final_norm': gain(ks[20], (D_MODEL,)),
    }


def reference(x, mem, positions, ffn1_norm, ffn1_w_gu, ffn1_w_down, mix_norm, w_in, b_fgate, w_fox_out, w_dsa_out, w_sb_out, w_out, ca_norm, mem_norm, ca_w_q, ca_w_kv, ca_w_o, ffn2_norm, ffn2_w_gu, ffn2_w_down, final_norm):
    for l in range(DEPTH):
        x = x + HALF_STEP * swiglu(rms_norm(x, ffn1_norm[l]), ffn1_w_gu[l], ffn1_w_down[l])
        x = x + hybrid_mixer(rms_norm(x, mix_norm[l]), positions, w_in[l], b_fgate[l], w_fox_out[l], w_dsa_out[l], w_sb_out[l], w_out[l])
        x = x + memory_cross_attention(rms_norm(x, ca_norm[l]), rms_norm(mem, mem_norm[l]), ca_w_q[l], ca_w_kv[l], ca_w_o[l])
        x = x + HALF_STEP * swiglu(rms_norm(x, ffn2_norm[l]), ffn2_w_gu[l], ffn2_w_down[l])
    return rms_norm(x, final_norm)
```

```cpp
#define MIX_ORDER 1
#include <hip/hip_runtime.h>
#include <cstdio>
#include <cstdint>
namespace pg8 {
#define PG8_LAS __attribute__((address_space(3)))
typedef unsigned short bf16_t;
typedef short bf16x8 __attribute__((ext_vector_type(8)));
typedef float f32x4 __attribute__((ext_vector_type(4)));
typedef unsigned u32x4 __attribute__((ext_vector_type(4)));
constexpr int BM = 256, BK = 64, HALF = 128, HTB = HALF * BK * 2  , STAGE_BYTES = 8 * HTB, NXCD = 8, WGM = 8;

__host__ __device__ __forceinline__ int lds_byte(int r, int c) { const int st = (r >> 4) * 2 + (c >> 5), rr = r & 15, cc = c & 31, ob = rr * 64 + cc * 2; return st * 1024 + (ob ^ (((ob >> 9) & 1) << 5)); }
__host__ __device__ __forceinline__ void stage_rc(int b, int& R, int& C) { const int st = b / 1024, sb = b % 1024, swz = sb ^ (((sb >> 9) & 1) << 5); R = (st >> 1) * 16 + swz / 64; C = (st & 1) * 32 + (swz % 64) / 2; }
__host__ __device__ __forceinline__ int perm32(int rho) { const int n = rho >> 4, i = rho & 15; return 8 * (i >> 2) + 4 * n + (i & 3); }

struct Unit { int pm, pn; };
struct Gemm { const bf16_t* A; const bf16_t* Bt; int M, N, K; };

struct StaticOrder {
    int nM, nN, nwg, G, c;
    __host__ __device__ void init(int M, int N, int G_, int c_) { nM = M / BM; nN = N / BM; nwg = nM * nN; G = G_; c = c_; }
    __host__ __device__ bool next(int i, Unit& u) const {
        const long L = (long)i * G + c; if (L >= nwg) return false;
        int wgid = (int)L; { const int q = nwg / NXCD, r = nwg % NXCD, xcd = wgid % NXCD, off = wgid / NXCD; wgid = (xcd < r ? xcd * (q + 1) : r * (q + 1) + (xcd - r) * q) + off; }
        const int nig = WGM * nN, gid = wgid / nig, fm = gid * WGM, gsz = (nM - fm) < WGM ? (nM - fm) : WGM;
        u.pm = fm + ((wgid % nig) % gsz); u.pn = (wgid % nig) / gsz; return true;
    }
    __device__ __forceinline__ void a_ready(const Unit&) const {}
    __device__ __forceinline__ void done(const Unit&) const {}
};

__device__ __forceinline__ unsigned cvt_pk_bf16(float lo, float hi) { unsigned r; asm volatile("v_cvt_pk_bf16_f32 %0, %1, %2" : "=v"(r) : "v"(lo), "v"(hi)); return r; }
typedef float f32x2 __attribute__((ext_vector_type(2)));

template <class Epi, class Sched, bool ALIGN_EPI = false, bool SP2 = false>
__device__ __forceinline__ void gemm_phase(PG8_LAS unsigned char* lds, const Gemm g, const Sched& S, const Epi& E) {
    int tid_ = threadIdx.x; asm volatile("" : "+v"(tid_));
    const int tid = tid_, wid = __builtin_amdgcn_readfirstlane(tid >> 6), lane = tid & 63, wr = wid >> 2, wc = wid & 3, fr = lane & 15, fq = lane >> 4;
    const int K = g.K, nt = K / BK;
    unsigned voffA[2], voffB[2];
#pragma unroll
    for (int i = 0; i < 2; ++i) { int R, C; stage_rc(tid * 16 + i * 8192, R, C); const int Rb = Epi::PERM ? ((R & ~31) + perm32(R & 31)) : R;
        voffA[i] = (unsigned)(R * K + C) * 2u; voffB[i] = (unsigned)(Rb * K + C) * 2u; }
    const size_t kstep = (size_t)(BK * 2);
    const size_t hstep = (size_t)HALF * K * 2;
    const size_t tstep = 2 * hstep;
    const unsigned ldsw = (unsigned)wid * 1024u;
    const int aoff = lds_byte(wr * 64 + fr, fq * 8), boff = lds_byte(wc * 32 + fr, fq * 8);
#define PG8_SA(b, h) (((b) * 2 + (h)) * HTB)
#define PG8_SB(b, h) ((4 + (b) * 2 + (h)) * HTB)
#define PG8_STAGE(bufoff, gbase, voff) do { _Pragma("unroll") for (int _i = 0; _i < 2; ++_i) \
        __builtin_amdgcn_global_load_lds((const unsigned*)((const char*)(gbase) + (voff)[_i]), (PG8_LAS unsigned*)(lds + (bufoff) + ldsw + _i * 8192), 16, 0, 0); } while (0)
#define PG8_LDA(dst, b, h) do { _Pragma("unroll") for (int m = 0; m < 4; ++m) _Pragma("unroll") for (int k = 0; k < 2; ++k) dst[m][k] = *(const PG8_LAS bf16x8*)(lds + PG8_SA(b, h) + aoff + m * 2048 + k * 1024); } while (0)
#define PG8_LDB(dst, b, h) do { _Pragma("unroll") for (int n = 0; n < 2; ++n) _Pragma("unroll") for (int k = 0; k < 2; ++k) dst[n][k] = *(const PG8_LAS bf16x8*)(lds + PG8_SB(b, h) + boff + n * 2048 + k * 1024); } while (0)
#define PG8_MMA(ai, bj, At, Bt) do { __builtin_amdgcn_s_setprio(1); _Pragma("unroll") for (int m = 0; m < 4; ++m) _Pragma("unroll") for (int n = 0; n < 2; ++n) _Pragma("unroll") for (int k = 0; k < 2; ++k) \
        acc[ai][bj][m][n] = __builtin_amdgcn_mfma_f32_16x16x32_bf16(Bt[n][k], At[m][k], acc[ai][bj][m][n], 0, 0, 0); __builtin_amdgcn_s_setprio(0); } while (0)
#define PG8_WAIT_V(n) asm volatile("s_waitcnt vmcnt(" #n ")" ::: "memory")
#define PG8_WAIT_L(n) asm volatile("s_waitcnt lgkmcnt(" #n ")" ::: "memory")
#define PG8_BAR __builtin_amdgcn_s_barrier()
#define PG8_SCHED __builtin_amdgcn_sched_barrier(0)
    Unit cur, nxt; int ui = 0;
    if (!S.next(0, cur)) return;
    f32x4 acc[2][2][4][2];
#pragma unroll
    for (int a = 0; a < 2; ++a)
#pragma unroll
        for (int b = 0; b < 2; ++b)
#pragma unroll
            for (int m = 0; m < 4; ++m)
#pragma unroll
                for (int n = 0; n < 2; ++n) acc[a][b][m][n] = (f32x4){0.f, 0.f, 0.f, 0.f};
    bf16x8 At[4][2], B0[2][2], B1[2][2];
    const char* cA = (const char*)g.A + (size_t)cur.pm * tstep; const char* cB = (const char*)g.Bt + (size_t)cur.pn * tstep;
    S.a_ready(cur);
    if constexpr (SP2) {
        PG8_STAGE(PG8_SB(0, 0), cB, voffB); PG8_STAGE(PG8_SB(0, 1), cB + hstep, voffB); PG8_STAGE(PG8_SA(0, 0), cA, voffA); PG8_STAGE(PG8_SA(0, 1), cA + hstep, voffA);
        if (wr == 1) PG8_BAR;
        PG8_WAIT_V(2); PG8_BAR;
        PG8_STAGE(PG8_SB(1, 0), cB + kstep, voffB); PG8_STAGE(PG8_SA(1, 0), cA + kstep, voffA); PG8_STAGE(PG8_SB(1, 1), cB + hstep + kstep, voffB);
        PG8_WAIT_V(6); PG8_BAR;
    } else {
        PG8_STAGE(PG8_SB(0, 0), cB, voffB); PG8_STAGE(PG8_SA(0, 0), cA, voffA); PG8_STAGE(PG8_SB(0, 1), cB + hstep, voffB); PG8_STAGE(PG8_SA(0, 1), cA + hstep, voffA);
        if (wr == 1) PG8_BAR;
        PG8_WAIT_V(4); PG8_BAR;
        PG8_STAGE(PG8_SB(1, 0), cB + kstep, voffB); PG8_STAGE(PG8_SA(1, 0), cA + kstep, voffA); PG8_STAGE(PG8_SB(1, 1), cB + hstep + kstep, voffB);
        PG8_WAIT_V(6); PG8_BAR;
    }
    for (;;) {
        const bool has_next = S.next(ui + 1, nxt);
        const char* nA = has_next ? (const char*)g.A + (size_t)nxt.pm * tstep : cA; const char* nB = has_next ? (const char*)g.Bt + (size_t)nxt.pn * tstep : cB;
#pragma unroll 1
        for (int t = 0; t < nt; t += 2) {
            const bool last = (t == nt - 2);
            const char* a1 = cA + (size_t)(t + 1) * kstep;
            const char* a2 = last ? nA : cA + (size_t)(t + 2) * kstep; const char* b2 = last ? nB : cB + (size_t)(t + 2) * kstep;
            const char* a3 = a2 + kstep; const char* b3 = b2 + kstep;
            if (last && has_next) S.a_ready(nxt);
            if constexpr (SP2) {
            PG8_LDB(B0, 0, 0); PG8_LDB(B1, 0, 1); PG8_SCHED; PG8_LDA(At, 0, 0); PG8_STAGE(PG8_SA(1, 1), a1 + hstep, voffA);
            PG8_WAIT_V(8); PG8_WAIT_L(0); PG8_BAR; PG8_MMA(0, 0, At, B0); PG8_MMA(0, 1, At, B1); PG8_BAR; PG8_SCHED;
            PG8_LDA(At, 0, 1); PG8_STAGE(PG8_SB(0, 0), b2, voffB); PG8_STAGE(PG8_SB(0, 1), b2 + hstep, voffB); PG8_STAGE(PG8_SA(0, 0), a2, voffA);
            PG8_WAIT_V(8); PG8_WAIT_L(0); PG8_BAR; PG8_MMA(1, 0, At, B0); PG8_MMA(1, 1, At, B1); PG8_BAR; PG8_SCHED;
            PG8_LDB(B0, 1, 0); PG8_LDB(B1, 1, 1); PG8_SCHED; PG8_LDA(At, 1, 0); PG8_STAGE(PG8_SA(0, 1), a2 + hstep, voffA);
            PG8_WAIT_V(8); PG8_WAIT_L(0); PG8_BAR; PG8_MMA(0, 0, At, B0); PG8_MMA(0, 1, At, B1); PG8_BAR; PG8_SCHED;
            PG8_LDA(At, 1, 1); PG8_STAGE(PG8_SB(1, 0), b3, voffB); PG8_STAGE(PG8_SB(1, 1), b3 + hstep, voffB); PG8_STAGE(PG8_SA(1, 0), a3, voffA);
            PG8_WAIT_V(8); PG8_WAIT_L(0); PG8_BAR; PG8_MMA(1, 0, At, B0); PG8_MMA(1, 1, At, B1); PG8_BAR; PG8_SCHED;
            } else {
            PG8_LDB(B0, 0, 0); PG8_SCHED; PG8_LDA(At, 0, 0); PG8_STAGE(PG8_SA(1, 1), a1 + hstep, voffA);
            PG8_WAIT_L(8); PG8_BAR; PG8_WAIT_L(0); PG8_MMA(0, 0, At, B0); PG8_BAR; PG8_SCHED;
            PG8_LDB(B1, 0, 1); PG8_STAGE(PG8_SB(0, 0), b2, voffB);
            PG8_BAR; PG8_WAIT_L(0); PG8_MMA(0, 1, At, B1); PG8_BAR;
            PG8_LDA(At, 0, 1); PG8_STAGE(PG8_SA(0, 0), a2, voffA);
            PG8_BAR; PG8_WAIT_L(0); PG8_MMA(1, 0, At, B0); PG8_BAR; PG8_SCHED;
            PG8_STAGE(PG8_SB(0, 1), b2 + hstep, voffB);
            PG8_WAIT_V(6); PG8_BAR; PG8_MMA(1, 1, At, B1); PG8_BAR;
            PG8_LDB(B0, 1, 0); PG8_SCHED; PG8_LDA(At, 1, 0); PG8_STAGE(PG8_SA(0, 1), a2 + hstep, voffA);
            PG8_WAIT_L(8); PG8_BAR; PG8_WAIT_L(0); PG8_MMA(0, 0, At, B0); PG8_BAR; PG8_SCHED;
            PG8_LDB(B1, 1, 1); PG8_STAGE(PG8_SB(1, 0), b3, voffB);
            PG8_BAR; PG8_WAIT_L(0); PG8_MMA(0, 1, At, B1); PG8_BAR;
            PG8_LDA(At, 1, 1); PG8_STAGE(PG8_SA(1, 0), a3, voffA);
            PG8_BAR; PG8_WAIT_L(0); PG8_MMA(1, 0, At, B0); PG8_BAR; PG8_SCHED;
            PG8_STAGE(PG8_SB(1, 1), b3 + hstep, voffB);
            PG8_WAIT_V(6); PG8_BAR; PG8_MMA(1, 1, At, B1); PG8_BAR;
            }
        }
        if constexpr (ALIGN_EPI) { if (wr == 0) PG8_BAR; }
        if constexpr (!Epi::AFTER_DRAIN) { E(acc, cur, wr, wc, fr, fq); S.done(cur); }
        if (!has_next) break;
#pragma unroll
        for (int a = 0; a < 2; ++a)
#pragma unroll
            for (int b = 0; b < 2; ++b)
#pragma unroll
                for (int m = 0; m < 4; ++m)
#pragma unroll
                    for (int n = 0; n < 2; ++n) acc[a][b][m][n] = (f32x4){0.f, 0.f, 0.f, 0.f};
        cur = nxt; cA = nA; cB = nB; ++ui;
        if constexpr (ALIGN_EPI) { if (wr == 1) PG8_BAR; }
    }
    PG8_WAIT_V(0);
    if constexpr (!ALIGN_EPI) { if (wr == 0) PG8_BAR; }
    PG8_BAR;
    if constexpr (Epi::AFTER_DRAIN) { E.fused(acc, cur, wr, wc, fr, fq, lds, wid, lane); S.done(cur); }
#undef PG8_SA
#undef PG8_SB
#undef PG8_STAGE
#undef PG8_LDA
#undef PG8_LDB
#undef PG8_MMA
#undef PG8_WAIT_V
#undef PG8_WAIT_L
#undef PG8_BAR
#undef PG8_SCHED
}
}

#define GAS __attribute__((address_space(1)))
#define LAS __attribute__((address_space(3)))
typedef unsigned short bf16;
typedef short bf16x8 __attribute__((ext_vector_type(8)));
typedef float f32x4 __attribute__((ext_vector_type(4)));
typedef float f32x2 __attribute__((ext_vector_type(2)));
typedef float f32x16 __attribute__((ext_vector_type(16)));
typedef unsigned u32x4 __attribute__((ext_vector_type(4)));
typedef unsigned u32x2 __attribute__((ext_vector_type(2)));
typedef __bf16 bf16x2_t __attribute__((ext_vector_type(2)));

#ifndef MK_PER_PHASE
#define MK_PER_PHASE 0
#endif

constexpr int BATCH = 4, SEQ = 4096, DM = 1024, DEPTH = 4, MTOK = BATCH * SEQ;
constexpr int DFF = 2816, NGU = 2 * DFF, DIN = 6734, NIN = 6912;
constexpr int NMEM = 256, MROWS = BATCH * NMEM;
constexpr float EPS = 1e-6f;
constexpr float LOG2E = 1.4426950408889634f, LN2 = 0.6931471805599453f;
constexpr float C2_64 = 0.125f * LOG2E;
constexpr float C2_128 = 0.08838834764831845f * LOG2E;
constexpr float WIDX_SCALE = 0.35355339059327373f * 0.125f;
constexpr int NTHREADS = 512, NWAVES = 8;

constexpr size_t MiB = (size_t)1 << 20;
constexpr size_t WS_CTL = 0, CTL_ZERO_BYTES = 1 * MiB;
constexpr size_t WS_COS = 1 * MiB, WS_SIN = 3 * MiB;
constexpr size_t WS_SSQ = 5 * MiB;
constexpr size_t WS_MEMB = 6 * MiB;
constexpr size_t WS_MEMSSQ = 8 * MiB;
constexpr size_t WS_LF = 9 * MiB;
constexpr size_t WS_WIDX = 10 * MiB;
constexpr size_t WS_MK = 11 * MiB, WS_MVT = 12 * MiB;
constexpr size_t WS_XB = 16 * MiB;
constexpr size_t WS_W = 48 * MiB;
constexpr size_t W_GU1 = 0, W_DN1 = W_GU1 + (size_t)NGU * DM * 2, W_IN = W_DN1 + (size_t)DM * DFF * 2, W_BR = W_IN + (size_t)NIN * DM * 2,
                 W_OUT = W_BR + (size_t)3 * DM * 384 * 2, W_CQ = W_OUT + (size_t)DM * DM * 2, W_CKV = W_CQ + (size_t)512 * DM * 2,
                 W_CO = W_CKV + (size_t)DM * DM * 2, W_GU2 = W_CO + (size_t)DM * 512 * 2, W_DN2 = W_GU2 + (size_t)NGU * DM * 2, W_END = W_DN2 + (size_t)DM * DFF * 2;
static_assert(W_END <= 56 * MiB, "weights region");
constexpr size_t WS_W2 = 104 * MiB;
constexpr size_t WS_R = 160 * MiB;
constexpr size_t WS_ACT = WS_R;
constexpr size_t WS_QKN = WS_R;
constexpr size_t WS_QKR = WS_R + 48 * MiB;
constexpr size_t WS_VT = WS_R + 88 * MiB;
constexpr size_t WS_GATES = WS_R + 120 * MiB;
constexpr size_t WS_MASK = WS_R + 216 * MiB;
constexpr size_t WS_OATT = WS_R + 224 * MiB;
constexpr size_t WS_MF = WS_R;
constexpr size_t WS_MB = WS_R + 64 * MiB;
constexpr size_t WS_CAQ = WS_R;
constexpr size_t WS_CAO = WS_R + 16 * MiB;
constexpr size_t WS_END = WS_R + 260 * MiB;

constexpr int CW_BAR = 4096;
constexpr int CW_QUEUE = 16384;
constexpr int CW_KINF = 20480;
constexpr int LDS_HIST = 131072;
constexpr int MISC_OFF = 139264 + 64;
constexpr int LDS_BYTES = 147456;

#define RLX_AGENT __ATOMIC_RELAXED, __HIP_MEMORY_SCOPE_AGENT
__device__ __forceinline__ unsigned pk2(float lo, float hi) { f32x2 v = {lo, hi}; bf16x2_t b = __builtin_convertvector(v, bf16x2_t); return __builtin_bit_cast(unsigned, b); }
__device__ __forceinline__ float bf2f(unsigned short h) { return __uint_as_float(((unsigned)h) << 16); }
__device__ __forceinline__ float wave_sum(float v) {
#pragma unroll
    for (int o = 1; o < 64; o <<= 1) v += __shfl_xor(v, o);
    return v;
}
__device__ __forceinline__ float fexp2(float x) { return __builtin_amdgcn_exp2f(x); }
__device__ __forceinline__ float flog2(float x) { return __builtin_amdgcn_logf(x); }
__device__ __forceinline__ float frcp(float x) { return __builtin_amdgcn_rcpf(x); }
__device__ __forceinline__ int tperm(int t) { return (t & ~12) | ((t & 4) << 1) | ((t & 8) >> 1); }

#define XB_TMO      128
#define XB_XCNT(j)  (256  + 64 * (j))
#define XB_XSUB(j)  (1280 + 64 * (j))
#define XB_XGEN(j)  (2304 + 64 * (j))
#define XB_TOP      3328
#define XB_TOPGEN   3392
#define XCD_BAR_WORDS 3456
#define XB_SPIN_CAP (1u << 18)

__device__ __forceinline__ unsigned xb_ld(unsigned* p)              { return __hip_atomic_load(p, __ATOMIC_RELAXED, __HIP_MEMORY_SCOPE_AGENT); }
__device__ __forceinline__ unsigned xb_add(unsigned* p, unsigned v) { return __hip_atomic_fetch_add(p, v, __ATOMIC_RELAXED, __HIP_MEMORY_SCOPE_AGENT); }
__device__ __forceinline__ unsigned xb_xcc_id() { return (unsigned)__builtin_amdgcn_s_getreg((3 << 11) | 20) & 0xFu; }
#define XB_SPIN(cond, bar) do { unsigned _sp = 0; while (cond) { __builtin_amdgcn_s_sleep(1); \
    if ((++_sp & 255u) == 0u) { if (xb_ld(&(bar)[XB_TMO])) break; if (_sp > XB_SPIN_CAP) { atomicAdd(&(bar)[XB_TMO], 1u); break; } } } } while (0)

struct XcdBarrier {
    unsigned* bar; unsigned x;
    volatile LAS unsigned* st;
};

__device__ __forceinline__ XcdBarrier xcd_barrier_post(unsigned* bar, volatile LAS unsigned* st) {
    XcdBarrier b; b.bar = bar; b.x = xb_xcc_id(); b.st = st;
    if (threadIdx.x == 0) (void)xb_add(&bar[XB_XCNT(b.x)], 1u);
    return b;
}
__device__ __forceinline__ void xcd_barrier_complete(unsigned* bar, unsigned x, unsigned& nloc, unsigned& nx) {
    const unsigned G = gridDim.x * gridDim.y * gridDim.z;
    unsigned sum, cnt, mine, sp = 0u;
    for (;;) {
        sum = 0u; cnt = 0u; mine = 0u;
#pragma unroll
        for (unsigned j = 0; j < 16; ++j) { const unsigned c = xb_ld(&bar[XB_XCNT(j)]); sum += c; cnt += (c > 0u) ? 1u : 0u; mine = (j == x) ? c : mine; }
        if (sum == G) break;
        __builtin_amdgcn_s_sleep(1);
        if ((++sp & 255u) == 0u) { if (xb_ld(&bar[XB_TMO])) break; if (sp > XB_SPIN_CAP) { atomicAdd(&bar[XB_TMO], 1u); break; } }
    }
    nloc = mine > 0u ? mine : 1u; nx = cnt > 0u ? cnt : 1u;
}

__device__ __forceinline__ void xcd_barrier(const XcdBarrier& b) {
    asm volatile("s_waitcnt vmcnt(0)" ::: "memory");
    __syncthreads();
    if (threadIdx.x == 0) {
        unsigned* bar = b.bar;
        __builtin_amdgcn_s_waitcnt(0);
        unsigned nloc = b.st[0], nx = b.st[1];
        if (nloc == 0u) { xcd_barrier_complete(bar, b.x, nloc, nx); b.st[0] = nloc; b.st[1] = nx; }
        const unsigned old = xb_add(&bar[XB_XSUB(b.x)], 1u);
        const unsigned gen = old / nloc;
        if (old + 1u == (gen + 1u) * nloc) {
            __builtin_amdgcn_fence(__ATOMIC_RELEASE, "agent");
            asm volatile("s_waitcnt vmcnt(0)" ::: "memory");
            const unsigned og = xb_add(&bar[XB_TOP], 1u);
            const unsigned tg = og / nx;
            if (og + 1u == (tg + 1u) * nx) xb_add(&bar[XB_TOPGEN], 1u);
            else XB_SPIN(xb_ld(&bar[XB_TOPGEN]) == tg, bar);
            __builtin_amdgcn_fence(__ATOMIC_ACQUIRE, "agent");
            xb_add(&bar[XB_XGEN(b.x)], 1u);
            asm volatile("s_waitcnt vmcnt(0)" ::: "memory");
        } else {
            XB_SPIN(xb_ld(&bar[XB_XGEN(b.x)]) == gen, bar);
            __builtin_amdgcn_fence(__ATOMIC_ACQUIRE, "agent");
            asm volatile("s_waitcnt vmcnt(0)" ::: "memory");
        }
    }
    __syncthreads();
}
typedef const pg8::f32x4 (&AccRef)[2][2][4][2];
#define EPI_GROUP(rb, base) int rb = (base); asm volatile("" : "+v"(rb))

__device__ __forceinline__ void rstd16x4(const float* ssq, int rb, float (&r)[4]) {
    f32x4 p[4];
#pragma unroll
    for (int m = 0; m < 4; ++m) p[m] = *(const GAS f32x4*)(ssq + (size_t)(rb + 16 * m) * 4);
#pragma unroll
    for (int m = 0; m < 4; ++m) r[m] = __builtin_amdgcn_rsqf(((p[m].x + p[m].y) + (p[m].z + p[m].w)) * (1.0f / DM) + EPS);
}
__device__ __forceinline__ float rstd16(const float* ssq, int row) {
    const f32x4 a = *(const GAS f32x4*)(ssq + (size_t)row * 4);
    return __builtin_amdgcn_rsqf(((a.x + a.y) + (a.z + a.w)) * (1.0f / DM) + EPS);
}
__device__ __forceinline__ u32x4 pack8(const float* h) { u32x4 w; w.x = pk2(h[0], h[1]); w.y = pk2(h[2], h[3]); w.z = pk2(h[4], h[5]); w.w = pk2(h[6], h[7]); return w; }
__device__ __forceinline__ float sigmoidf_(float x) { return frcp(1.f + fexp2(-x * LOG2E)); }
__device__ __forceinline__ float logsigmoidf_(float z) { return fminf(z, 0.f) - LN2 * flog2(1.f + fexp2(-fabsf(z) * LOG2E)); }
__device__ __forceinline__ void unpack8(const u32x4 w, f32x4& lo, f32x4& hi) {
    lo.x = __uint_as_float(w.x << 16); lo.y = __uint_as_float(w.x & 0xffff0000u); lo.z = __uint_as_float(w.y << 16); lo.w = __uint_as_float(w.y & 0xffff0000u);
    hi.x = __uint_as_float(w.z << 16); hi.y = __uint_as_float(w.z & 0xffff0000u); hi.z = __uint_as_float(w.w << 16); hi.w = __uint_as_float(w.w & 0xffff0000u);
}

struct EpiGU {
    static constexpr bool PERM = true, AFTER_DRAIN = false;
    bf16* act; const float* ssq;
#if defined(PROBE_EPITRIV)
    int triv;
#endif
    __device__ __forceinline__ void operator()(AccRef acc, const pg8::Unit& u, int wr, int wc, int fr, int fq) const {
        const int row0 = u.pm * 256 + wr * 64 + fr, col = u.pn * 128 + wc * 32 + fq * 8;
#if defined(PROBE_EPITRIV)
        if (triv) {
#if PROBE_EPITRIV == 2
            return;
#endif
#pragma unroll
            for (int ai = 0; ai < 2; ++ai)
#pragma unroll
                for (int m = 0; m < 4; ++m) { float h[8];
#pragma unroll
                    for (int n = 0; n < 2; ++n)
#pragma unroll
                        for (int j = 0; j < 4; ++j) h[4 * n + j] = acc[ai][0][m][n][j] * acc[ai][1][m][n][j];
                    *(GAS u32x4*)(act + (size_t)(row0 + ai * 128 + 16 * m) * DFF + col) = pack8(h); }
            return;
        }
#endif
#pragma unroll
        for (int ai = 0; ai < 2; ++ai) {
            EPI_GROUP(rb, row0 + ai * 128); float r4[4]; rstd16x4(ssq, rb, r4);
#pragma unroll
            for (int m = 0; m < 4; ++m) {
                const float r = r4[m]; float h[8];
#pragma unroll
                for (int n = 0; n < 2; ++n)
#pragma unroll
                    for (int j = 0; j < 4; ++j) { const float g = acc[ai][0][m][n][j] * r, uu = acc[ai][1][m][n][j] * r; h[4 * n + j] = g * sigmoidf_(g) * uu; }
#if defined(GU_NT)
                __builtin_nontemporal_store(pack8(h), (GAS u32x4*)(act + (size_t)(rb + 16 * m) * DFF + col));
#else
                *(GAS u32x4*)(act + (size_t)(rb + 16 * m) * DFF + col) = pack8(h);
#endif
            }
        }
    }
};
struct EpiRES {
    static constexpr bool PERM = true, AFTER_DRAIN = false;
    bf16* xb; float* ssq; float scale; LAS float* red;
    __device__ __forceinline__ void operator()(AccRef acc, const pg8::Unit& u, int wr, int wc, int fr, int fq) const {
        const int row0 = u.pm * 256 + wr * 64 + fr, col0 = u.pn * 256 + wc * 32 + fq * 8;
#pragma unroll
        for (int ai = 0; ai < 2; ++ai) {
            EPI_GROUP(rb, row0 + ai * 128);
            u32x4 xv[4][2];
#pragma unroll
            for (int m = 0; m < 4; ++m)
#pragma unroll
                for (int bj = 0; bj < 2; ++bj) xv[m][bj] = *(const GAS u32x4*)(xb + (size_t)(rb + 16 * m) * DM + col0 + bj * 128);
#pragma unroll
            for (int m = 0; m < 4; ++m) {
                const int row = rb + 16 * m; float ss = 0.f;
#pragma unroll
                for (int bj = 0; bj < 2; ++bj) {
                    f32x4 xl, xh; unpack8(xv[m][bj], xl, xh);
                    const f32x4 x0 = xl + acc[ai][bj][m][0] * scale, x1 = xh + acc[ai][bj][m][1] * scale;
                    ss += (x0.x * x0.x + x0.y * x0.y) + (x0.z * x0.z + x0.w * x0.w) + (x1.x * x1.x + x1.y * x1.y) + (x1.z * x1.z + x1.w * x1.w);
                    u32x4 w; w.x = pk2(x0.x, x0.y); w.y = pk2(x0.z, x0.w); w.z = pk2(x1.x, x1.y); w.w = pk2(x1.z, x1.w);
                    *(GAS u32x4*)(xb + (size_t)row * DM + col0 + bj * 128) = w;
                }
                ss += __shfl_xor(ss, 16); ss += __shfl_xor(ss, 32);
                if (fq == 0) red[(row - u.pm * 256) * 4 + wc] = ss;
            }
        }
        asm volatile("s_waitcnt lgkmcnt(0)" ::: "memory"); __builtin_amdgcn_s_barrier(); asm volatile("" ::: "memory");
        { const int t = threadIdx.x; if (t < 256) { const f32x4 v = *(const LAS f32x4*)(red + 4 * t); ssq[(size_t)(u.pm * 256 + t) * 4 + u.pn] = (v.x + v.y) + (v.z + v.w); } }
        asm volatile("s_waitcnt lgkmcnt(0)" ::: "memory"); __builtin_amdgcn_s_barrier(); asm volatile("" ::: "memory");
    }
};
struct EpiIN {
    static constexpr bool PERM = true, AFTER_DRAIN = false;
    bf16* qkn; bf16* qkr; bf16* vt; bf16* gates; float* lf; float* widx; const float* ssq; const float* cosT; const float* sinT; const float* bfg; unsigned* kinf;
    __device__ __forceinline__ void operator()(AccRef acc, const pg8::Unit& u, int wr, int wc, int fr, int fq) const {
        const int row0 = u.pm * 256 + wr * 64 + fr, pn = u.pn;
        if (pn < 6) {
            const int d0 = 32 * (wc & 1) + 8 * fq;
            float kmx[2] = {0.f, 0.f};
#pragma unroll
            for (int ai = 0; ai < 2; ++ai) {
                EPI_GROUP(rb, row0 + ai * 128); float r4[4]; rstd16x4(ssq, rb, r4);
#pragma unroll
                for (int m = 0; m < 4; ++m) {
                    const int row = rb + 16 * m; const float r = r4[m];
#pragma unroll
                    for (int bj = 0; bj < 2; ++bj) {
                        const int slot = 4 * pn + 2 * bj + (wc >> 1);
                        if (slot < 22) {
                            const float sc = r * (slot < 6 ? C2_64 : ((slot >= 12 && slot < 17) ? 0.125f : 1.0f));
                            float h[8];
#pragma unroll
                            for (int n = 0; n < 2; ++n)
#pragma unroll
                                for (int j = 0; j < 4; ++j) h[4 * n + j] = acc[ai][bj][m][n][j] * sc;
                            *(GAS u32x4*)(qkn + ((size_t)slot * MTOK + row) * 64 + d0) = pack8(h);
                            if (slot >= 6 && slot < 12) {
#pragma unroll
                                for (int e = 0; e < 8; ++e) kmx[bj] = fmaxf(kmx[bj], fabsf(h[e]));
                            }
                        }
                    }
                }
            }
#pragma unroll
            for (int bj = 0; bj < 2; ++bj) {
                const int slot = 4 * pn + 2 * bj + (wc >> 1);
                if (slot >= 6 && slot < 12) {
                    float v = kmx[bj];
#pragma unroll
                    for (int o = 1; o < 64; o <<= 1) v = fmaxf(v, __shfl_xor(v, o));
                    if ((threadIdx.x & 63) == 0) atomicMax(kinf + (u.pm >> 4) * 8 + (slot - 6), __float_as_uint(v * 1.01f));
                }
            }
        } else if (pn < 11) {
            const int hs = 4 * (pn - 6) + wc, i0 = 8 * fq;
            if (hs < 19) {
                const float scl = hs < 5 ? C2_64 : 1.0f;
#pragma unroll
                for (int ai = 0; ai < 2; ++ai) {
                    EPI_GROUP(rb, row0 + ai * 128); float r4[4]; rstd16x4(ssq, rb, r4);
#pragma unroll
                    for (int mp = 0; mp < 2; ++mp) {
                    EPI_GROUP(rb2, rb + 32 * mp);
                    f32x4 cv[2][2], sv[2][2];
#pragma unroll
                    for (int mm = 0; mm < 2; ++mm)
#pragma unroll
                        for (int n = 0; n < 2; ++n) { cv[mm][n] = *((const GAS f32x4*)(cosT + (size_t)(rb2 + 16 * mm) * 32 + i0) + n); sv[mm][n] = *((const GAS f32x4*)(sinT + (size_t)(rb2 + 16 * mm) * 32 + i0) + n); }
#pragma unroll
                    for (int mm = 0; mm < 2; ++mm) {
                        const int m = 2 * mp + mm;
                        const int row = rb2 + 16 * mm; const float r = r4[m] * scl;
                        float o1[8], o2[8];
#pragma unroll
                        for (int n = 0; n < 2; ++n) { const f32x4 c = cv[mm][n], s = sv[mm][n];
#pragma unroll
                            for (int j = 0; j < 4; ++j) { const float x1 = acc[ai][0][m][n][j] * r, x2 = acc[ai][1][m][n][j] * r; o1[4 * n + j] = x1 * c[j] - x2 * s[j]; o2[4 * n + j] = x2 * c[j] + x1 * s[j]; } }
                        if (hs == 18) {
                            bf16* dst = qkr + (size_t)18 * MTOK * 64 + (((size_t)(row >> 5) * 8 + fq) * 32 + (row & 31)) * 8;
                            *(GAS u32x4*)(dst) = pack8(o1); *(GAS u32x4*)(dst + 4 * 32 * 8) = pack8(o2);
                        } else {
                            bf16* dst = qkr + ((size_t)hs * MTOK + row) * 64 + i0;
                            *(GAS u32x4*)(dst) = pack8(o1); *(GAS u32x4*)(dst + 32) = pack8(o2);
                        }
                    }
                    }
                }
            } else {
                if (fq < 2) {
#pragma unroll
                    for (int ai = 0; ai < 2; ++ai) {
                        EPI_GROUP(rb, row0 + ai * 128); float r4[4]; rstd16x4(ssq, rb, r4);
#pragma unroll
                        for (int m = 0; m < 4; ++m) {
                            const int row = rb + 16 * m; const float r = r4[m];
#pragma unroll
                            for (int n = 0; n < 2; ++n)
#pragma unroll
                                for (int j = 0; j < 4; ++j) { const int i = 8 * fq + 4 * n + j; const float v = acc[ai][0][m][n][j] * r;
                                    if (i < 6) lf[(size_t)i * MTOK + row] = logsigmoidf_(v + bfg[i]);
                                    else if (i < 14) widx[(size_t)row * 8 + (i - 6)] = v * WIDX_SCALE; }
                        }
                    }
                }
            }
        } else if (pn < 15) {
            const int d0 = 32 * (wc & 1) + 8 * fq;
#pragma unroll
            for (int ai = 0; ai < 2; ++ai) {
                EPI_GROUP(rb, row0 + ai * 128); float r4[4]; rstd16x4(ssq, rb, r4);
#pragma unroll
                for (int m = 0; m < 4; ++m) {
                    const int row = rb + 16 * m; const float r = r4[m];
                    const int b = row >> 12, tp = tperm(row & 4095);
#pragma unroll
                    for (int bj = 0; bj < 2; ++bj) {
                        const int v = 4 * (pn - 11) + 2 * bj + (wc >> 1);
                        bf16* base = vt + ((size_t)(v * 4 + b) * 64 + d0) * SEQ + tp;
#pragma unroll
                        for (int n = 0; n < 2; ++n)
#pragma unroll
                            for (int j = 0; j < 4; ++j) base[(size_t)(4 * n + j) * SEQ] = (bf16)(pk2(acc[ai][bj][m][n][j] * r, 0.f) & 0xffffu);
                    }
                }
            }
        } else {
            const int colb = 256 * (pn - 15) + 32 * wc + 8 * fq;
#pragma unroll
            for (int ai = 0; ai < 2; ++ai) {
                EPI_GROUP(rb, row0 + ai * 128); float r4[4]; rstd16x4(ssq, rb, r4);
#pragma unroll
                for (int m = 0; m < 4; ++m) {
                    const int row = rb + 16 * m; const float r = r4[m];
#pragma unroll
                    for (int bj = 0; bj < 2; ++bj) {
                        float h[8];
#pragma unroll
                        for (int n = 0; n < 2; ++n)
#pragma unroll
                            for (int j = 0; j < 4; ++j) h[4 * n + j] = sigmoidf_(acc[ai][bj][m][n][j] * r);
                        *(GAS u32x4*)(gates + (size_t)row * 3072 + colb + 128 * bj) = pack8(h);
                    }
                }
            }
        }
    }
};
struct BranchOrder {
    pg8::StaticOrder S;
    __device__ __forceinline__ bool next(int i, pg8::Unit& u) const { pg8::Unit b; if (!S.next(i / 3, b)) return false; const int br = i % 3; u.pm = br * (MTOK / 256) + b.pm; u.pn = br * (DM / 256) + b.pn; return true; }
    __device__ __forceinline__ void a_ready(const pg8::Unit&) const {}
    __device__ __forceinline__ void done(const pg8::Unit&) const {}
};
struct EpiBR {
    static constexpr bool PERM = true, AFTER_DRAIN = false;
    const bf16* gates; float* mf; bf16* mb;
    __device__ __forceinline__ void operator()(AccRef acc, const pg8::Unit& u, int wr, int wc, int fr, int fq) const {
        const int mode = u.pn >> 2, pn = u.pn & 3, pm = u.pm & 63;
        const int row0 = pm * 256 + wr * 64 + fr, col0 = pn * 256 + wc * 32 + fq * 8;
#pragma unroll
        for (int ai = 0; ai < 2; ++ai) {
            EPI_GROUP(rb, row0 + ai * 128);
            u32x4 gv[4][2], pv[4][2];
#pragma unroll
            for (int m = 0; m < 4; ++m)
#pragma unroll
                for (int bj = 0; bj < 2; ++bj) { gv[m][bj] = *(const GAS u32x4*)(gates + (size_t)(rb + 16 * m) * 3072 + mode * DM + col0 + 128 * bj);
                    pv[m][bj] = (u32x4){0u, 0u, 0u, 0u}; if (mode > 0) pv[m][bj] = *(const GAS u32x4*)(mb + (size_t)(rb + 16 * m) * DM + col0 + 128 * bj); }
#pragma unroll
            for (int m = 0; m < 4; ++m)
#pragma unroll
                for (int bj = 0; bj < 2; ++bj) {
                    f32x4 g0, g1, p0, p1; unpack8(gv[m][bj], g0, g1); unpack8(pv[m][bj], p0, p1);
                    const f32x4 v0 = acc[ai][bj][m][0] * g0 + p0, v1 = acc[ai][bj][m][1] * g1 + p1;
                    u32x4 w; w.x = pk2(v0.x, v0.y); w.y = pk2(v0.z, v0.w); w.z = pk2(v1.x, v1.y); w.w = pk2(v1.z, v1.w);
                    *(GAS u32x4*)(mb + (size_t)(rb + 16 * m) * DM + col0 + 128 * bj) = w;
                }
        }
    }
};
struct EpiCQ {
    static constexpr bool PERM = true, AFTER_DRAIN = false;
    bf16* caq; const float* ssq;
    __device__ __forceinline__ void operator()(AccRef acc, const pg8::Unit& u, int wr, int wc, int fr, int fq) const {
        const int row0 = u.pm * 256 + wr * 64 + fr, d0 = 32 * wc + 8 * fq;
#pragma unroll
        for (int ai = 0; ai < 2; ++ai) {
            EPI_GROUP(rb, row0 + ai * 128); float r4[4]; rstd16x4(ssq, rb, r4);
#pragma unroll
            for (int m = 0; m < 4; ++m) {
                const int row = rb + 16 * m; const float r = r4[m] * C2_128;
#pragma unroll
                for (int bj = 0; bj < 2; ++bj) {
                    float h[8];
#pragma unroll
                    for (int n = 0; n < 2; ++n)
#pragma unroll
                        for (int j = 0; j < 4; ++j) h[4 * n + j] = acc[ai][bj][m][n][j] * r;
                    *(GAS u32x4*)(caq + ((size_t)(2 * u.pn + bj) * MTOK + row) * 128 + d0) = pack8(h);
                }
            }
        }
    }
};
struct EpiCKV {
    static constexpr bool PERM = true, AFTER_DRAIN = false;
    bf16* mk; bf16* mvt; const float* memssq;
    __device__ __forceinline__ void operator()(AccRef acc, const pg8::Unit& u, int wr, int wc, int fr, int fq) const {
        const int b = u.pm, d0 = 32 * wc + 8 * fq, two = u.pn >> 1;
#pragma unroll
        for (int ai = 0; ai < 2; ++ai)
#pragma unroll
            for (int m = 0; m < 4; ++m) {
                int mrow = ai * 128 + wr * 64 + m * 16 + fr; asm volatile("" : "+v"(mrow)); const float r = __builtin_amdgcn_rsqf(memssq[b * 256 + mrow] * (1.0f / DM) + EPS);
#pragma unroll
                for (int bj = 0; bj < 2; ++bj) {
                    const int h = 2 * (u.pn & 1) + bj;
                    if (!two) {
                        float hh[8];
#pragma unroll
                        for (int n = 0; n < 2; ++n)
#pragma unroll
                            for (int j = 0; j < 4; ++j) hh[4 * n + j] = acc[ai][bj][m][n][j] * r;
                        *(GAS u32x4*)(mk + ((size_t)(b * 4 + h) * 256 + mrow) * 128 + d0) = pack8(hh);
                    } else {
                        bf16* base = mvt + ((size_t)(b * 4 + h) * 128 + d0) * 256 + tperm(mrow);
#pragma unroll
                        for (int n = 0; n < 2; ++n)
#pragma unroll
                            for (int j = 0; j < 4; ++j) base[(size_t)(4 * n + j) * 256] = (bf16)(pk2(acc[ai][bj][m][n][j] * r, 0.f) & 0xffffu);
                    }
                }
            }
    }
};


__device__ __forceinline__ int srccol_gu(int n) { const int t = n >> 8, w = n & 255; return w < 128 ? 128 * t + w : DFF + 128 * t + (w - 128); }
__device__ __forceinline__ int srccol_in(int n) {
    const int pn = n >> 8, w = n & 255;
    if (pn < 6) { const int slot = 4 * pn + (w >> 6), d = w & 63;
        if (slot < 6) return 64 * slot + d; if (slot < 12) return 384 + 64 * (slot - 6) + d; if (slot < 17) return 2702 + 64 * (slot - 12) + d; if (slot < 22) return 3022 + 64 * (slot - 17) + d; return -1; }
    if (pn < 11) { const int bj = w >> 7, hs = 4 * (pn - 6) + ((w & 127) >> 5), i = w & 31, d = 32 * bj + i;
        if (hs < 5) return 1158 + 64 * hs + d; if (hs < 10) return 1478 + 64 * (hs - 5) + d; if (hs < 18) return 2118 + 64 * (hs - 10) + d; if (hs == 18) return 2630 + d;
        if (bj == 0) { if (i < 6) return 1152 + i; if (i < 14) return 2694 + (i - 6); }
        return -1; }
    if (pn < 15) { const int v = 4 * (pn - 11) + (w >> 6), d = w & 63;
        if (v < 6) return 768 + 64 * v + d; if (v < 11) return 1798 + 64 * (v - 6) + d; return 3342 + 64 * (v - 11) + d; }
    return 3662 + 256 * (pn - 15) + w;
}
template <int MAP>
__device__ __forceinline__ void conv_item(const float* W, int Ksrc, int Nsrc, bf16* WT, int Kdst, const float* gain, LAS float* scr, int kb, int nb, int lane) {
    const int k0 = 64 * kb, n0 = 32 * nb, n = n0 + (lane & 31);
    const int sc = MAP == 0 ? n : (MAP == 1 ? srccol_gu(n) : srccol_in(n));
    float v[32];
    const bool live = (sc >= 0) && (k0 < Ksrc);
    const GAS float* src = (const GAS float*)W + (size_t)(k0 + (lane >> 5)) * Nsrc + (live ? sc : 0);
#pragma unroll
    for (int i = 0; i < 32; ++i) v[i] = live ? src[(size_t)(2 * i) * Nsrc] : 0.f;
#pragma unroll
    for (int i = 0; i < 32; ++i) scr[(2 * i + (lane >> 5)) * 33 + (lane & 31)] = v[i];
    asm volatile("s_waitcnt lgkmcnt(0)" ::: "memory");
    const int c = lane & 7;
    f32x4 g0 = {1.f, 1.f, 1.f, 1.f}, g1 = g0;
    if (gain) { g0 = *(const GAS f32x4*)(gain + k0 + 8 * c); g1 = *(const GAS f32x4*)(gain + k0 + 8 * c + 4); }
#pragma unroll
    for (int j = 0; j < 4; ++j) { const int nn = (lane >> 3) + 8 * j; const LAS float* s = scr + (8 * c) * 33 + nn;
        u32x4 o; o.x = pk2(s[0 * 33] * g0.x, s[1 * 33] * g0.y); o.y = pk2(s[2 * 33] * g0.z, s[3 * 33] * g0.w); o.z = pk2(s[4 * 33] * g1.x, s[5 * 33] * g1.y); o.w = pk2(s[6 * 33] * g1.z, s[7 * 33] * g1.w);
        *(GAS u32x4*)(WT + (size_t)(n0 + nn) * Kdst + k0 + 8 * c) = o; }
    asm volatile("s_waitcnt lgkmcnt(0)" ::: "memory");
}
struct ConvMat { const float* W; const float* gain; bf16* WT; int Ksrc, Nsrc, Kdst, Ndst, map; };
__device__ __forceinline__ void conv_matrix(const ConvMat& cm, LAS float* scr, int gw, int NGW, int lane) {
    const int nblk = cm.Ndst / 32, nit = (cm.Kdst / 64) * nblk;
    for (int it = gw; it < nit; it += NGW) {
        const int kb = it / nblk, nb = it % nblk;
        if (cm.map == 0) conv_item<0>(cm.W, cm.Ksrc, cm.Nsrc, cm.WT, cm.Kdst, cm.gain, scr, kb, nb, lane);
        else if (cm.map == 1) conv_item<1>(cm.W, cm.Ksrc, cm.Nsrc, cm.WT, cm.Kdst, cm.gain, scr, kb, nb, lane);
        else conv_item<2>(cm.W, cm.Ksrc, cm.Nsrc, cm.WT, cm.Kdst, cm.gain, scr, kb, nb, lane);
    }
}

#define MFMA32(a, b, c) __builtin_amdgcn_mfma_f32_32x32x16_bf16((a), (b), (c), 0, 0, 0)
__device__ __forceinline__ int crow(int r, int hi) { return (r & 3) + 8 * (r >> 2) + 4 * hi; }

template <int NDT>
__device__ __forceinline__ void store_ot(bf16* Oh, int opitch, int q, int hi, const f32x16* o, float inv) {
#pragma unroll
    for (int dt = 0; dt < NDT; ++dt)
#pragma unroll
        for (int rg = 0; rg < 4; ++rg) {
            u32x2 w; w.x = pk2(o[dt][4 * rg] * inv, o[dt][4 * rg + 1] * inv); w.y = pk2(o[dt][4 * rg + 2] * inv, o[dt][4 * rg + 3] * inv);
            *(GAS u32x2*)(Oh + (size_t)q * opitch + 32 * dt + 8 * rg + 4 * hi) = w;
        }
}

__device__ __forceinline__ float xhalf_max(float x) { const auto rr = __builtin_amdgcn_permlane32_swap(__float_as_uint(x), __float_as_uint(x), false, false); return fmaxf(__uint_as_float(rr[0]), __uint_as_float(rr[1])); }
__device__ __forceinline__ float xhalf_sumf(float x) { const auto rr = __builtin_amdgcn_permlane32_swap(__float_as_uint(x), __float_as_uint(x), false, false); return __uint_as_float(rr[0]) + __uint_as_float(rr[1]); }
__device__ __forceinline__ float xhalf_other(float x, int hi) { const auto rr = __builtin_amdgcn_permlane32_swap(__float_as_uint(x), __float_as_uint(x), false, false); return __uint_as_float(hi ? rr[0] : rr[1]); }

#ifndef FOX_TERM_SLOT
#define FOX_TERM_SLOT 3
#endif
#ifndef RESCALE_THR
#define RESCALE_THR 5.0f
#endif
#ifndef DSA_MFMA_SUM
#define DSA_MFMA_SUM 1
#endif
template <int NDT> struct FlashState { float m, l; bool started; f32x16 o[NDT]; f32x16 ol; f32x16 negm; };

template <int D, int MODE>
__device__ __forceinline__ void flash_qk(f32x16& p0, f32x16& p1, const f32x16& negm, const LAS unsigned char* Tb, const int* koff, const bf16x8* qr, const int t, const int qw0, const int q, const int hi, const LAS float* ncl2) {
    constexpr int ND0 = D / 16;
    if (MODE == 0) {
#pragma unroll
        for (int rg = 0; rg < 4; ++rg) { const f32x4 c0 = *(const LAS f32x4*)(ncl2 + 64 * t + 8 * rg + 4 * hi), c1 = *(const LAS f32x4*)(ncl2 + 64 * t + 32 + 8 * rg + 4 * hi);
#pragma unroll
            for (int j = 0; j < 4; ++j) { p0[4 * rg + j] = c0[j]; p1[4 * rg + j] = c1[j]; } }
    } else {
#pragma unroll
        for (int r = 0; r < 16; ++r) { p0[r] = 0.f; p1[r] = 0.f; }
    }
#pragma unroll
    for (int d0 = 0; d0 < ND0; ++d0) {
        const bf16x8 kf0 = *(const LAS bf16x8*)(Tb + koff[d0]), kf1 = *(const LAS bf16x8*)(Tb + koff[d0] + 512);
        p0 = MFMA32(kf0, qr[d0], p0); p1 = MFMA32(kf1, qr[d0], p1);
        if (D == 128) __builtin_amdgcn_sched_barrier(0);
    }
    if (MODE == 0) {
        if (64 * t + 63 > qw0) {
#pragma unroll
            for (int r = 0; r < 16; ++r) { const int kv = 64 * t + crow(r, hi); if (kv > q) p0[r] = -INFINITY; if (kv + 32 > q) p1[r] = -INFINITY; }
        }
    }
}
template <int D, int MODE>
__device__ __forceinline__ void flash_sv(FlashState<D / 32>& S, f32x16& p0, f32x16& p1, const float mref, const LAS unsigned char* Tb, const int* voff, const int hi, const unsigned long long mw) {
    constexpr int NDT = D / 32;
    float mx = fmaxf(fmaxf(p0[0], p1[0]), fmaxf(p0[1], p1[1]));
#pragma unroll
    for (int r = 2; r < 16; r += 2) mx = fmaxf(fmaxf(mx, p0[r]), fmaxf(p1[r], fmaxf(p0[r + 1], p1[r + 1])));
    mx = xhalf_max(mx);
    const float rel = mx - S.m; (void)mref;
    const float dl = S.started ? (rel > RESCALE_THR ? rel : 0.f) : rel;
    bool skip = false;
    if (MODE == 0) skip = S.started && __all(rel < -150.0f);
    S.started = true;
    if (skip) return;
    if (__any(dl != 0.f)) {
        const float alpha = fexp2(-dl); S.m += dl;
#pragma unroll
        for (int dt = 0; dt < NDT; ++dt)
#pragma unroll
            for (int r = 0; r < 16; ++r) S.o[dt][r] *= alpha;
        if (MODE == 1) S.l *= alpha;
        else {
#pragma unroll
            for (int r = 0; r < 16; ++r) S.ol[r] *= alpha;
        }
    }
    { const float m = S.m;
#pragma unroll
        for (int r = 0; r < 16; ++r) { p0[r] = fexp2(p0[r] - m); p1[r] = fexp2(p1[r] - m); }
    }
    if (MODE == 1) {
        const unsigned wlo = ((unsigned)mw) >> (4 * hi), whi = ((unsigned)(mw >> 32)) >> (4 * hi);
#pragma unroll
        for (int r = 0; r < 16; ++r) { const int bit = 8 * (r >> 2) + (r & 3);
            p0[r] = __uint_as_float(__float_as_uint(p0[r]) & (unsigned)__builtin_amdgcn_sbfe((int)wlo, bit, 1));
            p1[r] = __uint_as_float(__float_as_uint(p1[r]) & (unsigned)__builtin_amdgcn_sbfe((int)whi, bit, 1)); }
    }
    if (MODE == 1) { float rs = 0.f;
#pragma unroll
        for (int r = 0; r < 16; ++r) rs += p0[r] + p1[r];
        S.l += rs; }
    u32x4 pw[4];
#pragma unroll
    for (int s = 0; s < 2; ++s) {
        pw[s] = (u32x4){pk2(p0[8 * s], p0[8 * s + 1]), pk2(p0[8 * s + 2], p0[8 * s + 3]), pk2(p0[8 * s + 4], p0[8 * s + 5]), pk2(p0[8 * s + 6], p0[8 * s + 7])};
        pw[2 + s] = (u32x4){pk2(p1[8 * s], p1[8 * s + 1]), pk2(p1[8 * s + 2], p1[8 * s + 3]), pk2(p1[8 * s + 4], p1[8 * s + 5]), pk2(p1[8 * s + 6], p1[8 * s + 7])};
    }
#pragma unroll
    for (int g = 0; g < 4; ++g)
#pragma unroll
        for (int dt = 0; dt < NDT; ++dt) {
            const bf16x8 vf = *(const LAS bf16x8*)(Tb + D * 128 + voff[g] + 512 * dt);
            S.o[dt] = MFMA32(vf, __builtin_bit_cast(bf16x8, pw[g]), S.o[dt]);
            if (D == 128) __builtin_amdgcn_sched_barrier(0);
        }
    if (MODE != 1) {
        const unsigned one2 = ((threadIdx.x & 31) == 0) ? 0x3f803f80u : 0u;
        const bf16x8 vones = __builtin_bit_cast(bf16x8, (u32x4){one2, one2, one2, one2});
#pragma unroll
        for (int g = 0; g < 4; ++g) S.ol = MFMA32(vones, __builtin_bit_cast(bf16x8, pw[g]), S.ol);
    }
}

template <int MODE>
__device__ __forceinline__ void flash_tile3(FlashState<2>& S, bf16x8 (&kf)[8], const LAS unsigned char* Tb, const LAS unsigned char* Tn, const bool next_act, const int* koff, const bf16x8* qr,
                                            const int t, const int qw0, const int q, const int hi, const unsigned long long mw, const LAS float* ncl2, const bool act) {
    bool do_pv = false; u32x4 pw[4]; bf16x8 vf[8];
    if (act) {
        f32x16 p0, p1;
        if (MODE == 0) {
#pragma unroll
            for (int rg = 0; rg < 4; ++rg) { const f32x4 c0 = *(const LAS f32x4*)(ncl2 + 64 * t + 8 * rg + 4 * hi), c1 = *(const LAS f32x4*)(ncl2 + 64 * t + 32 + 8 * rg + 4 * hi);
#pragma unroll
                for (int j = 0; j < 4; ++j) { p0[4 * rg + j] = c0[j]; p1[4 * rg + j] = c1[j]; } }
        } else {
#pragma unroll
            for (int r = 0; r < 16; ++r) { p0[r] = 0.f; p1[r] = 0.f; }
        }
#pragma unroll
        for (int d0 = 0; d0 < 4; ++d0) { p0 = MFMA32(kf[2 * d0], qr[d0], p0); p1 = MFMA32(kf[2 * d0 + 1], qr[d0], p1); }
        if (MODE == 0) {
            if (64 * t + 63 > qw0) {
#pragma unroll
                for (int r = 0; r < 16; ++r) { const int kv = 64 * t + crow(r, hi); if (kv > q) p0[r] = -INFINITY; if (kv + 32 > q) p1[r] = -INFINITY; }
            }
        }
        float mx = fmaxf(fmaxf(p0[0], p1[0]), fmaxf(p0[1], p1[1]));
#pragma unroll
        for (int r = 2; r < 16; r += 2) mx = fmaxf(fmaxf(mx, p0[r]), fmaxf(p1[r], fmaxf(p0[r + 1], p1[r + 1])));
        mx = xhalf_max(mx);
        const float rel = mx - S.m;
        const float dl = S.started ? (rel > RESCALE_THR ? rel : 0.f) : rel;
        bool skip = false;
        if (MODE == 0) skip = S.started && __all(rel < -150.0f);
        S.started = true;
        if (!skip) {
            do_pv = true;
#pragma unroll
            for (int g = 0; g < 4; ++g) { vf[2 * g] = *(const LAS bf16x8*)(Tb + 8192 + koff[g]); vf[2 * g + 1] = *(const LAS bf16x8*)(Tb + 8192 + koff[g] + 512); }
            __builtin_amdgcn_sched_barrier(0);
            if (__any(dl != 0.f)) {
                const float alpha = fexp2(-dl); S.m += dl;
#pragma unroll
                for (int dt = 0; dt < 2; ++dt)
#pragma unroll
                    for (int r = 0; r < 16; ++r) S.o[dt][r] *= alpha;
                if (MODE == 1 && !DSA_MFMA_SUM) S.l *= alpha;
                else {
#pragma unroll
                    for (int r = 0; r < 16; ++r) S.ol[r] *= alpha;
                }
            }
            { const float m = S.m;
#pragma unroll
                for (int r = 0; r < 16; ++r) { p0[r] = fexp2(p0[r] - m); p1[r] = fexp2(p1[r] - m); } }
            if (MODE == 1) {
                const unsigned wlo = ((unsigned)mw) >> (4 * hi), whi = ((unsigned)(mw >> 32)) >> (4 * hi);
#pragma unroll
                for (int r = 0; r < 16; ++r) { const int bit = 8 * (r >> 2) + (r & 3);
                    p0[r] = __uint_as_float(__float_as_uint(p0[r]) & (unsigned)__builtin_amdgcn_sbfe((int)wlo, bit, 1));
                    p1[r] = __uint_as_float(__float_as_uint(p1[r]) & (unsigned)__builtin_amdgcn_sbfe((int)whi, bit, 1)); }
#if !DSA_MFMA_SUM
                float rs = 0.f;
#pragma unroll
                for (int r = 0; r < 16; ++r) rs += p0[r] + p1[r];
                S.l += rs;
#endif
            }
#pragma unroll
            for (int s = 0; s < 2; ++s) {
                pw[s] = (u32x4){pk2(p0[8 * s], p0[8 * s + 1]), pk2(p0[8 * s + 2], p0[8 * s + 3]), pk2(p0[8 * s + 4], p0[8 * s + 5]), pk2(p0[8 * s + 6], p0[8 * s + 7])};
                pw[2 + s] = (u32x4){pk2(p1[8 * s], p1[8 * s + 1]), pk2(p1[8 * s + 2], p1[8 * s + 3]), pk2(p1[8 * s + 4], p1[8 * s + 5]), pk2(p1[8 * s + 6], p1[8 * s + 7])};
            }
        }
    }
    if (next_act) {
#pragma unroll
        for (int d0 = 0; d0 < 4; ++d0) { kf[2 * d0] = *(const LAS bf16x8*)(Tn + koff[d0]); kf[2 * d0 + 1] = *(const LAS bf16x8*)(Tn + koff[d0] + 512); }
    }
    __builtin_amdgcn_sched_barrier(0);
    if (do_pv) {
#pragma unroll
        for (int g = 0; g < 4; ++g) { S.o[0] = MFMA32(vf[2 * g], __builtin_bit_cast(bf16x8, pw[g]), S.o[0]); S.o[1] = MFMA32(vf[2 * g + 1], __builtin_bit_cast(bf16x8, pw[g]), S.o[1]); }
        if (MODE != 1 || DSA_MFMA_SUM) {
            const unsigned one2 = ((threadIdx.x & 31) == 0) ? 0x3f803f80u : 0u;
            const bf16x8 vones = __builtin_bit_cast(bf16x8, (u32x4){one2, one2, one2, one2});
#pragma unroll
            for (int g = 0; g < 4; ++g) S.ol = MFMA32(vones, __builtin_bit_cast(bf16x8, pw[g]), S.ol);
        }
    }
}

template <int D, int MODE>
__device__ __forceinline__ void flash_unit(LAS unsigned char* lds, const bf16* Qh, const bf16* Kh, const bf16* VTh, const int vtp, bf16* Oh, const int opitch,
                                           const int q0, const int NT, const unsigned long long* mrow, const LAS float* ncl2, const float kinf = 0.f) {
    constexpr int KB = D * 128, NCH = D / 64, ND0 = D / 16, NDT = D / 32, CPR = D / 8;
    int tid_ = threadIdx.x; asm volatile("" : "+v"(tid_)); const int tid = tid_, lane = tid & 63, r32 = lane & 31, hi = lane >> 5, wid = __builtin_amdgcn_readfirstlane(tid >> 6);
    const int qw0 = q0 + 32 * wid, q = qw0 + r32;
    bf16x8 qr[ND0];
#pragma unroll
    for (int d0 = 0; d0 < ND0; ++d0) qr[d0] = *(const GAS bf16x8*)(Qh + (size_t)q * D + 16 * d0 + 8 * hi);
    unsigned ksrc[NCH], vsrc[NCH]; int kdst[NCH], vdst[NCH];
#pragma unroll
    for (int j = 0; j < NCH; ++j) { const int idx = tid + 512 * j; const int c = idx % CPR, kv = idx / CPR, cc = idx & 7, d = idx >> 3;
        ksrc[j] = (unsigned)(kv * D + 8 * c) * 2u; kdst[j] = c * 1024 + ((kv ^ (2 * c)) & 63) * 16; vsrc[j] = (unsigned)(d * vtp + 8 * cc) * 2u; vdst[j] = KB + cc * (D * 16) + (d ^ (2 * cc)) * 16; }
    int koff[ND0], voff_[D == 64 ? 1 : 4];
#pragma unroll
    for (int d0 = 0; d0 < ND0; ++d0) koff[d0] = (2 * d0 + hi) * 1024 + ((r32 ^ (4 * d0 + 2 * hi)) & 63) * 16;
    if (D != 64) {
#pragma unroll
        for (int g = 0; g < 4; ++g) voff_[D == 64 ? 0 : g] = (2 * g + hi) * (D * 16) + (r32 ^ (4 * g + 2 * hi)) * 16;
    }
    const int* voff = (D == 64) ? koff : voff_;
#define FL_TILE(i) ((MODE == 0) ? (NT - 1 - (i)) : (i))
#define FL_ACT(i) ((MODE != 0) || (64 * FL_TILE(i) <= qw0 + 31))
#define FL_LOAD(KR, VR, i) do { const int t_ = FL_TILE(i); const GAS char* kb_ = (const GAS char*)(Kh + (size_t)t_ * 64 * D); const GAS char* vb_ = (const GAS char*)(VTh + (size_t)t_ * 64); \
        _Pragma("unroll") for (int j_ = 0; j_ < NCH; ++j_) { KR[j_] = *(const GAS u32x4*)(kb_ + ksrc[j_]); VR[j_] = *(const GAS u32x4*)(vb_ + vsrc[j_]); } } while (0)
#define FL_STORE(KR, VR, b) do { _Pragma("unroll") for (int j_ = 0; j_ < NCH; ++j_) { *(LAS u32x4*)(lds + (b) * 2 * KB + kdst[j_]) = KR[j_]; *(LAS u32x4*)(lds + (b) * 2 * KB + vdst[j_]) = VR[j_]; } } while (0)
    FlashState<NDT> S; S.m = 0.f; S.l = 0.f; S.started = false;
#pragma unroll
    for (int r = 0; r < 16; ++r) { S.ol[r] = 0.f; S.negm[r] = 0.f; }
#pragma unroll
    for (int dt = 0; dt < NDT; ++dt)
#pragma unroll
        for (int r = 0; r < 16; ++r) S.o[dt][r] = 0.f;
    const unsigned mqo = (unsigned)q * 512u;
#define MQ(i) (*(const GAS unsigned long long*)((const GAS char*)mrow + (size_t)(i) * 8 + mqo))
    if constexpr (MODE == 2) {
        u32x4 kr[NCH], vr[NCH];
        for (int t = 0; t < NT; ++t) { FL_LOAD(kr, vr, t); FL_STORE(kr, vr, t); }
        __syncthreads();
        for (int t = 0; t < NT; ++t) { f32x16 p0, p1; const float mr = S.m; flash_qk<D, MODE>(p0, p1, S.negm, lds + t * 2 * KB, koff, qr, t, qw0, q, hi, ncl2); flash_sv<D, MODE>(S, p0, p1, mr, lds + t * 2 * KB, voff, hi, 0ull); }
        __syncthreads();
    } else {
        u32x4 kE[NCH], vE[NCH], kO[NCH], vO[NCH];
        unsigned long long wE = 0ull, wO = 0ull;
        bf16x8 kf[8];
        float qbound = 0.f; bool stop = false;
        LAS int* tflags = (LAS int*)(lds + 65536 + 16384 + 64);
        if (MODE == 0) { float s1 = 0.f;
#pragma unroll
            for (int d0 = 0; d0 < ND0; ++d0)
#pragma unroll
                for (int e = 0; e < 8; ++e) s1 += __uint_as_float(((unsigned)(unsigned short)qr[d0][e] & 0x7fffu) << 16);
            qbound = xhalf_sumf(s1) * kinf; }
        if (wid & 4) __builtin_amdgcn_s_setprio(1);
        FL_LOAD(kE, vE, 0); if (MODE == 1) wE = MQ(0);
        if (1 < NT) { FL_LOAD(kO, vO, 1); if (MODE == 1) wO = MQ(1); }
        FL_STORE(kE, vE, 0);
        if (1 < NT) FL_STORE(kO, vO, 1);
        if (2 < NT) FL_LOAD(kE, vE, 2);
        if (3 < NT) FL_LOAD(kO, vO, 3);
        __syncthreads();
        if (FL_ACT(0)) {
#pragma unroll
            for (int d0 = 0; d0 < 4; ++d0) { kf[2 * d0] = *(const LAS bf16x8*)(lds + koff[d0]); kf[2 * d0 + 1] = *(const LAS bf16x8*)(lds + koff[d0] + 512); }
        }
#define FL_STEP(i, SL, KP, VP, WL) do { \
            const unsigned long long mwc_ = WL; \
            if (MODE == 1) { if ((i) + 2 < NT) WL = MQ((i) + 2); } \
            { const bool nact_ = ((i) + 1 < NT) && FL_ACT((i) + 1); \
              flash_tile3<MODE>(S, kf, lds + (SL) * 2 * KB, lds + (((SL) + 1) & 3) * 2 * KB, nact_, koff, qr, FL_TILE(i), qw0, q, hi, mwc_, ncl2, FL_ACT(i)); } \
            if ((i) + 2 < NT) FL_STORE(KP, VP, ((SL) + 2) & 3);                                      \
            if ((i) + 4 < NT) FL_LOAD(KP, VP, (i) + 4);                                              \
            if (MODE == 0 && (SL) == FOX_TERM_SLOT) { const int t_ = FL_TILE(i); bool dead_ = false; \
                if (t_ > 0 && S.started) dead_ = __all(qbound + ncl2[64 * t_ - 1] - S.m < -150.0f); \
                if (lane == 0) tflags[(SL) * 8 + wid] = dead_ ? 1 : 0; } \
            __syncthreads(); \
            if (MODE == 0 && (SL) == FOX_TERM_SLOT) { const LAS int* fl_ = tflags + (SL) * 8; stop = (fl_[0] & fl_[1] & fl_[2] & fl_[3] & fl_[4] & fl_[5] & fl_[6] & fl_[7]) != 0; } \
            } while (0)
        for (int it = 0; it < NT; it += 4) {
            FL_STEP(it, 0, kE, vE, wE);
            if (stop || it + 1 >= NT) break;
            FL_STEP(it + 1, 1, kO, vO, wO);
            if (stop || it + 2 >= NT) break;
            FL_STEP(it + 2, 2, kE, vE, wE);
            if (stop || it + 3 >= NT) break;
            FL_STEP(it + 3, 3, kO, vO, wO);
            if (stop) break;
        }
        __builtin_amdgcn_s_setprio(0);
#undef FL_STEP
    }
    const float l = xhalf_sumf((MODE == 1 && !DSA_MFMA_SUM) ? S.l : (hi == 0 ? S.ol[0] : 0.f));
    store_ot<NDT>(Oh, opitch, q, hi, S.o, frcp(l));
#undef FL_LOAD
#undef FL_STORE
#undef FL_TILE
#undef FL_ACT
#undef MQ
}

__device__ __forceinline__ void sb_tile(float& carry, f32x16* o, const LAS unsigned char* Tb, const int* koff, const int* voff, const bf16x8* qr, const int j, const int q, const int hi, const int qw0) {
    f32x16 p0, p1;
#pragma unroll
    for (int r = 0; r < 16; ++r) { p0[r] = 0.f; p1[r] = 0.f; }
#pragma unroll
    for (int d0 = 0; d0 < 4; ++d0) {
        const bf16x8 kf0 = *(const LAS bf16x8*)(Tb + koff[d0]), kf1 = *(const LAS bf16x8*)(Tb + koff[d0] + 512);
        p0 = MFMA32(kf0, qr[d0], p0); p1 = MFMA32(kf1, qr[d0], p1);
    }
    float x[32], lb[32];
#pragma unroll
    for (int e = 0; e < 32; ++e) {
        const float z = e < 16 ? p0[e & 15] : p1[e & 15];
        const float lbv = logsigmoidf_(z);
        x[e] = lbv - z; lb[e] = lbv;
    }
    if (64 * j + 63 >= qw0) {
#pragma unroll
        for (int e = 0; e < 32; ++e) { const int kv = 64 * j + 32 * (e >> 4) + crow(e & 15, hi); if (!(kv < q)) { x[e] = 0.f; lb[e] = -INFINITY; } }
    }
    float gs[8], pr[8];
#pragma unroll
    for (int gl = 0; gl < 8; ++gl) gs[gl] = (x[4 * gl] + x[4 * gl + 1]) + (x[4 * gl + 2] + x[4 * gl + 3]);
#pragma unroll
    for (int gl = 0; gl < 8; ++gl) pr[gl] = xhalf_other(gs[gl], hi);
    float run = carry;
#pragma unroll
    for (int gl = 7; gl >= 0; --gl) {
        const float sg = run + (hi == 0 ? pr[gl] : 0.f);
        const float s3 = sg, s2 = s3 + x[4 * gl + 3], s1 = s2 + x[4 * gl + 2], s0 = s1 + x[4 * gl + 1];
        x[4 * gl + 3] = fexp2((lb[4 * gl + 3] + s3) * LOG2E); x[4 * gl + 2] = fexp2((lb[4 * gl + 2] + s2) * LOG2E);
        x[4 * gl + 1] = fexp2((lb[4 * gl + 1] + s1) * LOG2E); x[4 * gl] = fexp2((lb[4 * gl] + s0) * LOG2E);
        run += gs[gl] + pr[gl];
    }
    carry = run;
    u32x4 pw[4];
#pragma unroll
    for (int g = 0; g < 4; ++g) pw[g] = (u32x4){pk2(x[8 * g], x[8 * g + 1]), pk2(x[8 * g + 2], x[8 * g + 3]), pk2(x[8 * g + 4], x[8 * g + 5]), pk2(x[8 * g + 6], x[8 * g + 7])};
#pragma unroll
    for (int g = 0; g < 4; ++g)
#pragma unroll
        for (int dt = 0; dt < 2; ++dt) {
            const bf16x8 vf = *(const LAS bf16x8*)(Tb + 8192 + voff[g] + 512 * dt);
            o[dt] = MFMA32(vf, __builtin_bit_cast(bf16x8, pw[g]), o[dt]);
        }
}
__device__ __forceinline__ void sb_unit(LAS unsigned char* lds, const bf16* Qh, const bf16* Kh, const bf16* VTh, bf16* Oh, const int q0) {
    constexpr int D = 64, KB = 8192;
    int tid_ = threadIdx.x; asm volatile("" : "+v"(tid_)); const int tid = tid_, lane = tid & 63, r32 = lane & 31, hi = lane >> 5, wid = __builtin_amdgcn_readfirstlane(tid >> 6);
    const int qw0 = q0 + 32 * wid, q = qw0 + r32;
    bf16x8 qr[4];
#pragma unroll
    for (int d0 = 0; d0 < 4; ++d0) qr[d0] = *(const GAS bf16x8*)(Qh + (size_t)q * D + 16 * d0 + 8 * hi);
    const int c_ = tid & 7, kv_ = tid >> 3;
    const unsigned ksrc = (unsigned)(kv_ * D + 8 * c_) * 2u; const int kdst = c_ * 1024 + ((kv_ ^ (2 * c_)) & 63) * 16;
    const unsigned vsrc = (unsigned)(kv_ * SEQ + 8 * c_) * 2u; const int vdst = KB + c_ * (D * 16) + (kv_ ^ (2 * c_)) * 16;
    int koff[4];
#pragma unroll
    for (int d0 = 0; d0 < 4; ++d0) koff[d0] = (2 * d0 + hi) * 1024 + ((r32 ^ (4 * d0 + 2 * hi)) & 63) * 16;
    const int* voff = koff;
    LAS int* flags = (LAS int*)(lds + 4 * KB);
    u32x4 kreg, vreg;
#define SB_LOAD(t) do { kreg = *(const GAS u32x4*)((const GAS char*)(Kh + (size_t)(t) * 64 * D) + ksrc); vreg = *(const GAS u32x4*)((const GAS char*)(VTh + (size_t)(t) * 64) + vsrc); } while (0)
#define SB_STORE(b) do { *(LAS u32x4*)(lds + (b) * 2 * KB + kdst) = kreg; *(LAS u32x4*)(lds + (b) * 2 * KB + vdst) = vreg; } while (0)
    float carry = 0.f; bool wdone = false; f32x16 o[2];
#pragma unroll
    for (int dt = 0; dt < 2; ++dt)
#pragma unroll
        for (int r = 0; r < 16; ++r) o[dt][r] = 0.f;
    const int jtop = (q0 >> 6) + 3;
    SB_LOAD(jtop); SB_STORE(0); __syncthreads();
    int it = 0;
    for (int j = jtop; j >= 0; --j, ++it) {
        const int buf = it & 1;
        if (j > 0) SB_LOAD(j - 1);
        const bool started = (64 * j <= qw0);
        if (started && !wdone) sb_tile(carry, o, lds + buf * 2 * KB, koff, voff, qr, j, q, hi, qw0);
        wdone = started && __all(carry < -104.0f);
        const bool done = wdone;
        if (buf && lane == 0) flags[wid] = done ? 1 : 0;
        if (j > 0) SB_STORE(buf ^ 1);
        __syncthreads();
        if (buf) {
            const int alld = flags[0] & flags[1] & flags[2] & flags[3] & flags[4] & flags[5] & flags[6] & flags[7];
            if (alld) break;
        }
    }
    store_ot<2>(Oh, 384, q, hi, o, 1.0f);
    __syncthreads();
#undef SB_LOAD
#undef SB_STORE
}

__device__ __forceinline__ unsigned fkey(float x) { const unsigned b = __float_as_uint(x); return b ^ ((unsigned)((int)b >> 31) | 0x80000000u); }
__device__ __forceinline__ float xhalf_sum(float x) { const auto rr = __builtin_amdgcn_permlane32_swap(__float_as_uint(x), __float_as_uint(x), false, false); return __uint_as_float(rr[0]) + __uint_as_float(rr[1]); }
__device__ __forceinline__ unsigned wave_sum_u32(unsigned v) {
    unsigned x = v;
    x += (unsigned)__builtin_amdgcn_update_dpp(0, (int)x, 0x111, 0xf, 0xf, true);
    x += (unsigned)__builtin_amdgcn_update_dpp(0, (int)x, 0x112, 0xf, 0xf, true);
    x += (unsigned)__builtin_amdgcn_update_dpp(0, (int)x, 0x114, 0xf, 0xf, true);
    x += (unsigned)__builtin_amdgcn_update_dpp(0, (int)x, 0x118, 0xf, 0xf, true);
    return (unsigned)__builtin_amdgcn_readlane((int)x, 15) + (unsigned)__builtin_amdgcn_readlane((int)x, 31) + (unsigned)__builtin_amdgcn_readlane((int)x, 47) + (unsigned)__builtin_amdgcn_readlane((int)x, 63);
}
typedef short s16x2 __attribute__((ext_vector_type(2)));
#define IDX_SCORES(KB_) do { const int key = 32 * s + r32; \
        f32x16 y_; _Pragma("unroll") for (int r = 0; r < 16; ++r) y_[r] = 0.f; \
        _Pragma("unroll") for (int rt = 0; rt < 2; ++rt) { \
            f32x16 acc; _Pragma("unroll") for (int r = 0; r < 16; ++r) acc[r] = 0.f; \
            _Pragma("unroll") for (int d0 = 0; d0 < 4; ++d0) acc = MFMA32(qa[rt][d0], KB_[d0], acc); \
            _Pragma("unroll") for (int s2 = 0; s2 < 2; ++s2) { u32x4 xp; \
                _Pragma("unroll") for (int jj = 0; jj < 4; ++jj) { const s16x2 pz = {0, 0}; \
                    const unsigned pkd = pk2(acc[8 * s2 + 2 * jj], acc[8 * s2 + 2 * jj + 1]); \
                    xp[jj] = __builtin_bit_cast(unsigned, __builtin_elementwise_max(__builtin_bit_cast(s16x2, pkd), pz)); } \
                y_ = MFMA32(wf[rt][s2], __builtin_bit_cast(bf16x8, xp), y_); } \
        } \
        if (32 * s + 31 > t0) {         \
            _Pragma("unroll") for (int r = 0; r < 4; ++r) if (key > t0 + 4 * hi + r) y_[r] = __uint_as_float(0xffffffffu); } \
        _Pragma("unroll") for (int r = 0; r < 4; ++r) sc[(4 * hi + r) * 4096 + key] = y_[r]; \
        } while (0)
struct IdxPre { bf16x8 k0[4], k1[4], k2[4]; bf16x8 qa[2][4]; f32x4 w0, w1; };
#define IDX_KLOAD(KR, ss) do { if ((ss) < nsub) { _Pragma("unroll") for (int d0 = 0; d0 < 4; ++d0) KR[d0] = *(const GAS bf16x8*)(kbase + (size_t)(ss) * 2048 + 512 * d0); } } while (0)
__device__ __forceinline__ void idx_preload(IdxPre& P, const bf16* QI, const bf16* KI, const float* WI, const int b, const int t0) {
    int tid_ = threadIdx.x; asm volatile("" : "+v"(tid_)); const int tid = tid_, lane = tid & 63, r32 = lane & 31, hi = lane >> 5, wid = __builtin_amdgcn_readfirstlane(tid >> 6);
    const int nk = t0 + 8, nsub = ((nk + 63) >> 6) * 2;
    const size_t tok0 = (size_t)b * SEQ + t0;
    const bf16* kbase = KI + ((size_t)b * 128 * 8 + hi) * 256 + (size_t)r32 * 8;
#define IDX_KLOADZ(KR, ss) do { if ((ss) < nsub) { _Pragma("unroll") for (int d0 = 0; d0 < 4; ++d0) KR[d0] = *(const GAS bf16x8*)(kbase + (size_t)(ss) * 2048 + 512 * d0); } \
        else { _Pragma("unroll") for (int d0 = 0; d0 < 4; ++d0) KR[d0] = (bf16x8){0, 0, 0, 0, 0, 0, 0, 0}; } } while (0)
    IDX_KLOADZ(P.k0, wid); IDX_KLOADZ(P.k1, wid + 8); IDX_KLOADZ(P.k2, wid + 16);
#undef IDX_KLOADZ
    const int h = r32 >> 2, qq = r32 & 3, qp = r32 & 7;
#pragma unroll
    for (int rt = 0; rt < 2; ++rt)
#pragma unroll
        for (int d0 = 0; d0 < 4; ++d0) P.qa[rt][d0] = *(const GAS bf16x8*)(QI + ((size_t)h * MTOK + tok0 + 4 * rt + qq) * 64 + 16 * d0 + 8 * hi);
    P.w0 = *(const GAS f32x4*)(WI + (tok0 + qp) * 8); P.w1 = *(const GAS f32x4*)(WI + (tok0 + qp) * 8 + 4);
}
__device__ __forceinline__ void idx_unit(LAS unsigned char* lds, IdxPre& P, const bf16* QI, const bf16* KI, const float* WI, unsigned long long* MASK, const int b, const int t0,
                                         const bool has_next, const int nb, const int nt0, const int what = 3) {
    int tid_ = threadIdx.x; asm volatile("" : "+v"(tid_)); const int tid = tid_, lane = tid & 63, r32 = lane & 31, hi = lane >> 5, wid = __builtin_amdgcn_readfirstlane(tid >> 6);
    LAS float* sc = (LAS float*)lds;
    const int nk = t0 + 8, nsub = ((nk + 63) >> 6) * 2;
    if (what & 1) {
        const bf16* kbase = KI + ((size_t)b * 128 * 8 + hi) * 256 + (size_t)r32 * 8;
        bf16x8 k0[4], k1[4], k2[4], k3_[4];
#pragma unroll
        for (int d0 = 0; d0 < 4; ++d0) { k0[d0] = P.k0[d0]; k1[d0] = P.k1[d0]; k2[d0] = P.k2[d0]; }
        int s = wid;
        bf16x8 qa[2][4]; bf16x8 wf[2][2];
#pragma unroll
        for (int rt = 0; rt < 2; ++rt)
#pragma unroll
            for (int d0 = 0; d0 < 4; ++d0) qa[rt][d0] = P.qa[rt][d0];
        { const int qp = r32 & 7;
          const f32x4 w0 = P.w0, w1 = P.w1;
          const float wh[2][2] = {{hi ? w0.y : w0.x, hi ? w0.w : w0.z}, {hi ? w1.y : w1.x, hi ? w1.w : w1.z}};
#pragma unroll
          for (int rt = 0; rt < 2; ++rt)
#pragma unroll
              for (int s2 = 0; s2 < 2; ++s2) { u32x4 f = {0u, 0u, 0u, 0u};
                  if (r32 < 8 && (qp >> 2) == rt) { const int q0_ = qp & 3;
#pragma unroll
                      for (int j = 0; j < 8; ++j) if ((j & 3) == q0_) { const unsigned bits = pk2(wh[s2][j >> 2], 0.f) & 0xffffu; f[j >> 1] |= (j & 1) ? (bits << 16) : bits; } }
                  wf[rt][s2] = __builtin_bit_cast(bf16x8, f); }
        }
        while (s < nsub) {
            IDX_KLOAD(k3_, s + 24); IDX_SCORES(k0); s += 8; if (s >= nsub) break;
            IDX_KLOAD(k0, s + 24); IDX_SCORES(k1); s += 8; if (s >= nsub) break;
            IDX_KLOAD(k1, s + 24); IDX_SCORES(k2); s += 8; if (s >= nsub) break;
            IDX_KLOAD(k2, s + 24); IDX_SCORES(k3_); s += 8;
        }
    }
    __syncthreads();
    for (int rs_ = 0; rs_ < ((what & 4) ? 2 : 1); ++rs_)
    if (what & 2) {
        const int t = t0 + wid, n = t + 1;
        const LAS float* row = sc + wid * 4096 + lane;
        GAS unsigned long long* mout = (GAS unsigned long long*)MASK + ((size_t)b * SEQ + t) * 64;
        const int nwords = ((t | 255) >> 6) + 1;
        const int nreg = (n + 63) >> 6;
        unsigned long long myword = 0ull;
        if (n <= 256) {
            if (lane < nwords) { const int rem = n - 64 * lane; myword = rem >= 64 ? ~0ull : (rem > 0 ? ((1ull << rem) - 1ull) : 0ull); }
        } else {
            unsigned k[64];
#pragma unroll
            for (int g = 0; g < 4; ++g) {
                if (nreg > 16 * g) {
                    float v[16];
#pragma unroll
                    for (int j = 0; j < 16; ++j) v[j] = row[64 * (16 * g + j)];
#pragma unroll
                    for (int j = 0; j < 16; ++j) k[16 * g + j] = (16 * g + j < nreg) ? fkey(v[j]) : 0u;
                } else {
#pragma unroll
                    for (int j = 0; j < 16; ++j) k[16 * g + j] = 0u;
                }
            }
            unsigned T = 0u, cge = (unsigned)n;
#define CNT_BLOCK(g) do { unsigned long long mm_[16]; \
                _Pragma("unroll") for (int j = 0; j < 16; ++j) asm volatile("v_cmp_le_u32_e64 %0, %1, %2" : "=s"(mm_[j]) : "s"(cand), "v"(k[16 * (g) + j])); \
                asm volatile("s_nop 4"); __builtin_amdgcn_sched_barrier(0);        \
                _Pragma("unroll") for (int j = 0; j < 16; ++j) c += (unsigned)__builtin_popcountll(mm_[j]); \
                __builtin_amdgcn_sched_barrier(0); } while (0)
#define CNT_ALL() do { CNT_BLOCK(0); if (nreg > 16) { CNT_BLOCK(1); if (nreg > 32) { CNT_BLOCK(2); if (nreg > 48) CNT_BLOCK(3); } } } while (0)
            unsigned plo[16], phi[16];
#define IDX_TRANSPOSE(G, PL) do { unsigned w_[16]; \
                _Pragma("unroll") for (int i = 0; i < 16; ++i) w_[i] = (k[32 * (G) + i] >> 16) | (k[32 * (G) + 16 + i] & 0xffff0000u); \
                _Pragma("unroll") for (int st = 0; st < 4; ++st) { const int s_ = 8 >> st; const unsigned m_ = st == 0 ? 0x00ff00ffu : (st == 1 ? 0x0f0f0f0fu : (st == 2 ? 0x33333333u : 0x55555555u)); \
                    _Pragma("unroll") for (int i = 0; i < 16; ++i) if ((i & s_) == 0) { const unsigned t_ = ((w_[i] >> s_) ^ w_[i + s_]) & m_; w_[i + s_] ^= t_; w_[i] ^= (t_ << s_); } } \
                _Pragma("unroll") for (int b_ = 0; b_ < 16; ++b_) PL[b_] = w_[b_]; } while (0)
            IDX_TRANSPOSE(0, plo);
            if (nreg > 32) { IDX_TRANSPOSE(1, phi); } else {
#pragma unroll
                for (int b_ = 0; b_ < 16; ++b_) phi[b_] = 0u; }
#undef IDX_TRANSPOSE
            unsigned alo = 0xffffffffu, ahi = nreg > 32 ? 0xffffffffu : 0u, above = 0u, T16 = 0u;
#pragma unroll
            for (int bit = 15; bit >= 0; --bit) {
                const unsigned xlo = alo & plo[bit], xhi = ahi & phi[bit];
                const unsigned c1 = wave_sum_u32((unsigned)__builtin_popcount(xlo) + (unsigned)__builtin_popcount(xhi));
                if (above + c1 >= 256u) { T16 |= 1u << bit; alo = xlo; ahi = xhi; }
                else { above += c1; alo ^= xlo; ahi ^= xhi; }
            }
            const unsigned nC = wave_sum_u32((unsigned)__builtin_popcount(alo) + (unsigned)__builtin_popcount(ahi));
            const unsigned cnt_hi = above, need1 = 256u - cnt_hi;
            T = T16 << 16; cge = cnt_hi + nC;
            if (T16 == 0u) {
                T = 0u; cge = (unsigned)n;
#pragma unroll 1
                for (int bit = 31; bit >= 0; --bit) { const unsigned cand = T | (1u << bit); unsigned c = 0u; CNT_ALL(); if (c >= 256u) { T = cand; cge = c; } }
            } else if (nC > need1) {
                if (nC <= 64u) {
                    unsigned ck = 0u; int slot = 0;
#pragma unroll
                    for (int j = 0; j < 64; ++j) {
                        unsigned long long mk_ = __ballot((((j < 32 ? alo : ahi) >> (j & 31)) & 1u) != 0u);
                        while (mk_) { const int l_ = __builtin_ctzll(mk_); const unsigned v_ = (unsigned)__builtin_amdgcn_readlane((int)k[j], l_);
                            { unsigned keep_; asm volatile("s_mov_b32 %1, m0\n\ts_mov_b32 m0, %3\n\ts_nop 4\n\tv_writelane_b32 %0, %2, m0\n\ts_mov_b32 m0, %1" : "+v"(ck), "=&s"(keep_) : "s"(v_), "s"(slot)); }
                            ++slot; mk_ &= mk_ - 1ull; }
                    }
#pragma unroll 1
                    for (int bit = 15; bit >= 0; --bit) {
                        const unsigned cand = T | (1u << bit);
                        const unsigned c = cnt_hi + (unsigned)__popcll(__ballot(ck >= cand));
                        if (c >= 256u) { T = cand; cge = c; }
                    }
                } else {
#pragma unroll 1
                    for (int bit = 15; bit >= 0; --bit) {
                        const unsigned cand = T | (1u << bit);
                        unsigned c = 0u;
                        CNT_ALL();
                        if (c >= 256u) { T = cand; cge = c; }
                    }
                }
            }
            unsigned mlo = 0u, mhi = 0u;
            if (cge == 256u) {
                const unsigned cand = T;
#pragma unroll
                for (int g = 0; g < 4; ++g) if (16 * g < nreg) {
                    unsigned long long mm_[16];
#pragma unroll
                    for (int j = 0; j < 16; ++j) asm volatile("v_cmp_le_u32_e64 %0, %1, %2" : "=s"(mm_[j]) : "s"(cand), "v"(k[16 * g + j]));
                    __builtin_amdgcn_sched_barrier(0);
#pragma unroll
                    for (int j = 0; j < 16; ++j) { asm volatile("s_nop 1\n\tv_writelane_b32 %0, %1, %2" : "+v"(mlo) : "s"((unsigned)mm_[j]), "i"(16 * g + j)); asm volatile("v_writelane_b32 %0, %1, %2" : "+v"(mhi) : "s"((unsigned)(mm_[j] >> 32)), "i"(16 * g + j)); }
                    __builtin_amdgcn_sched_barrier(0);
                }
            } else {
                unsigned cgt = 0u;
#pragma unroll
                for (int j = 0; j < 64; ++j) cgt += (unsigned)__popcll(__ballot(k[j] > T));
                const unsigned need = 256u - cgt;
                unsigned tie_run = 0u; const unsigned long long lt = (1ull << lane) - 1ull;
#pragma unroll
                for (int j = 0; j < 64; ++j) {
                    const bool eq = (k[j] == T);
                    const unsigned long long beq = __ballot(eq);
                    const bool sel = (k[j] > T) || (eq && (tie_run + (unsigned)__popcll(beq & lt)) < need);
                    tie_run += (unsigned)__popcll(beq);
                    const unsigned long long w_ = __ballot(sel);
                    asm volatile("s_nop 4\n\tv_writelane_b32 %0, %1, %2" : "+v"(mlo) : "s"((unsigned)w_), "i"(j)); asm volatile("v_writelane_b32 %0, %1, %2" : "+v"(mhi) : "s"((unsigned)(w_ >> 32)), "i"(j));
                }
            }
            myword = ((unsigned long long)mhi << 32) | mlo;
#undef CNT_BLOCK
#undef CNT_ALL
        }
        if (lane < nwords) mout[lane] = myword;
    }
    if (has_next) idx_preload(P, QI, KI, WI, nb, nt0);
    __syncthreads();
}
#undef IDX_KLOAD


struct Args { const float* in[22]; float* out; unsigned char* ws; int ph_lo, ph_hi; };
constexpr int NPHASES = 1 + DEPTH * 12 + 1;

constexpr int CV_NIT[12] = {(DM / 64) * (NGU / 32), (DFF / 64) * (DM / 32), (DM / 64) * (NIN / 32), 6 * (DM / 32), 6 * (DM / 32), 6 * (DM / 32), (DM / 64) * (DM / 32), (DM / 64) * (512 / 32),
                            (DM / 64) * (DM / 32), (512 / 64) * (DM / 32), (DM / 64) * (NGU / 32), (DFF / 64) * (DM / 32)};
constexpr int cv_start(int i) { int s = 0; for (int j = 0; j < i; ++j) s += CV_NIT[j]; return s; }
constexpr int CV_TOTAL = cv_start(12);
__device__ __forceinline__ void conv_layer(const Args& a, int l, LAS float* scr, int gw, int NGW, int lane) {
    const size_t L = (size_t)l;
    for (int g = gw; g < CV_TOTAL; g += NGW) {
        ConvMat cm; size_t off; const float* W0; const float* G0 = nullptr; int it;
#define CVCASE(i, wi, GSET, OFF, KS, NS, KD, ND, MP) if (g < cv_start(i + 1)) { it = g - cv_start(i); W0 = a.in[wi]; asm volatile("" : "+s"(W0)); GSET; off = (OFF); cm.Ksrc = (KS); cm.Nsrc = (NS); cm.Kdst = (KD); cm.Ndst = (ND); cm.map = (MP); }
        CVCASE(0, 4, { G0 = a.in[3]; asm volatile("" : "+s"(G0)); }, W_GU1, DM, NGU, DM, NGU, 1)
        else CVCASE(1, 5, {}, W_DN1, DFF, DM, DFF, DM, 0)
        else CVCASE(2, 7, { G0 = a.in[6]; asm volatile("" : "+s"(G0)); }, W_IN, DM, DIN, DM, NIN, 2)
        else CVCASE(3, 9, {}, W_BR, 384, DM, 384, DM, 0)
        else CVCASE(4, 10, {}, W_BR + (size_t)DM * 384 * 2, 320, DM, 384, DM, 0)
        else CVCASE(5, 11, {}, W_BR + (size_t)2 * DM * 384 * 2, 320, DM, 384, DM, 0)
        else CVCASE(6, 12, {}, W_OUT, DM, DM, DM, DM, 0)
        else CVCASE(7, 15, { G0 = a.in[13]; asm volatile("" : "+s"(G0)); }, W_CQ, DM, 512, DM, 512, 0)
        else CVCASE(8, 16, { G0 = a.in[14]; asm volatile("" : "+s"(G0)); }, W_CKV, DM, DM, DM, DM, 0)
        else CVCASE(9, 17, {}, W_CO, 512, DM, 512, DM, 0)
        else CVCASE(10, 19, { G0 = a.in[18]; asm volatile("" : "+s"(G0)); }, W_GU2, DM, NGU, DM, NGU, 1)
        else CVCASE(11, 20, {}, W_DN2, DFF, DM, DFF, DM, 0)
        else break;
#undef CVCASE
        cm.W = W0 + L * ((size_t)cm.Ksrc * cm.Nsrc); cm.gain = G0 ? G0 + L * DM : (const float*)nullptr; cm.WT = (bf16*)(a.ws + ((l & 1) ? WS_W2 : WS_W) + off);
        const int nblk = cm.Ndst / 32, kb = it / nblk, nb = it % nblk;
        if (cm.map == 0) conv_item<0>(cm.W, cm.Ksrc, cm.Nsrc, cm.WT, cm.Kdst, cm.gain, scr, kb, nb, lane);
        else if (cm.map == 1) conv_item<1>(cm.W, cm.Ksrc, cm.Nsrc, cm.WT, cm.Kdst, cm.gain, scr, kb, nb, lane);
        else conv_item<2>(cm.W, cm.Ksrc, cm.Nsrc, cm.WT, cm.Kdst, cm.gain, scr, kb, nb, lane);
    }
}

constexpr int MIX_NLV = 48, MIX_NUNITS = 1024, MIX_NCONV = 512;
#ifndef MIX_ORDER
#define MIX_ORDER 1
#endif
#if MIX_ORDER == 0
__constant__ const unsigned char MIX_LV_TYPE[48] = {1,1,1,1,1,1,1,1,0,1,0,0,0,0,1,0,0,0,0,1,0,0,1,0,1,0,1,0,1,0,2,2,2,2,2,2,2,2,2,2,2,2,2,2,2,2,1,0};
__constant__ const unsigned char MIX_LV_QB[48] = {15,14,13,12,11,10,9,8,15,7,14,13,12,11,6,10,9,8,7,5,6,5,4,4,3,3,2,2,1,1,15,14,13,12,11,10,9,8,7,6,5,4,3,2,1,0,0,0};
__constant__ const unsigned short MIX_LV_START[49] = {0,20,40,60,80,100,120,140,160,184,204,228,252,276,300,320,344,368,392,416,436,460,484,504,528,548,572,592,616,636,660,680,700,720,740,760,780,800,820,840,860,880,900,920,940,960,980,1000,1024};
#else
__constant__ const unsigned char MIX_LV_TYPE[48] = {1,0,1,0,1,0,1,0,1,0,1,0,1,0,1,0,1,0,1,0,1,0,1,0,2,2,2,2,2,2,2,2,2,2,2,2,2,2,2,2,1,0,1,0,1,0,1,0};
__constant__ const unsigned char MIX_LV_QB[48] = {15,15,14,14,13,13,12,12,11,11,10,10,9,9,8,8,7,7,6,6,5,5,4,4,15,14,13,12,11,10,9,8,7,6,5,4,3,2,1,0,3,3,2,2,1,1,0,0};
__constant__ const unsigned short MIX_LV_START[49] = {0,20,44,64,88,108,132,152,176,196,220,240,264,284,308,328,352,372,396,416,440,460,484,504,528,548,568,588,608,628,648,668,688,708,728,748,768,788,808,828,848,868,892,912,936,956,980,1000,1024};
#endif

#define WSO unsigned char* ws = a.ws; asm volatile("" : "+s"(ws)); float* x = a.out
#define xb ((bf16*)(ws + WS_XB))
#define ssq ((float*)(ws + WS_SSQ))
#define cosT ((float*)(ws + WS_COS))
#define sinT ((float*)(ws + WS_SIN))
#define memb ((bf16*)(ws + WS_MEMB))
#define memssq ((float*)(ws + WS_MEMSSQ))
#define lfb ((float*)(ws + WS_LF))
#define widx ((float*)(ws + WS_WIDX))
#define mk ((bf16*)(ws + WS_MK))
#define mvt ((bf16*)(ws + WS_MVT))
#define wl (ws + ((l & 1) ? WS_W2 : WS_W))
#define act ((bf16*)(ws + WS_ACT))
#define qkn ((bf16*)(ws + WS_QKN))
#define qkr ((bf16*)(ws + WS_QKR))
#define vt ((bf16*)(ws + WS_VT))
#define gates ((bf16*)(ws + WS_GATES))
#define maskb ((unsigned long long*)(ws + WS_MASK))
#define oatt ((bf16*)(ws + WS_OATT))
#define mf ((float*)(ws + WS_MF))
#define mb ((bf16*)(ws + WS_MB))
#define caq ((bf16*)(ws + WS_CAQ))
#define cao ((bf16*)(ws + WS_CAO))
__global__ void __launch_bounds__(NTHREADS, 2) mk_fwd(Args a) {
    extern __shared__ __attribute__((aligned(16))) unsigned char lds_raw[];
    LAS unsigned char* lds = (LAS unsigned char*)lds_raw;
    constexpr int G = 256, NGW = G * NWAVES; const int bx = blockIdx.x;
    if (threadIdx.x < 32) ((volatile LAS unsigned*)(lds + MISC_OFF))[threadIdx.x] = 0u;
    __syncthreads();
    (void)xcd_barrier_post((unsigned*)(a.ws + WS_CTL) + CW_BAR, (volatile LAS unsigned*)(lds + MISC_OFF) + 8);
#define TIDS int tid = threadIdx.x; asm volatile("" : "+v"(tid)); const int lane = tid & 63, wave = __builtin_amdgcn_readfirstlane(tid >> 6), gw = bx * NWAVES + wave; (void)lane; (void)gw

#if MK_PER_PHASE
    const int lo = a.ph_lo, hi_ph = a.ph_hi;
    int pid = 0;
#define PH_ON (lo <= pid && pid < hi_ph)
#else
#define PH_ON true
#endif
#ifndef TEST_SITE
#define TEST_SITE (-1)
#endif
#define SITE(k) (TEST_SITE < 0 || TEST_SITE == (k))
#ifndef PROBE_DUP
#define PROBE_DUP (-1)
#endif
#ifndef PROBE_REPS
#define PROBE_REPS 2
#endif
#define NREP(k) ((PROBE_DUP == (k)) ? PROBE_REPS : 1)
#ifndef QUEUE_AHEAD
#define QUEUE_AHEAD 0
#endif
#ifndef GEMM_ALIGN
#define GEMM_ALIGN true
#endif
#ifndef GEMM_SP2
#define GEMM_SP2 true
#endif
#ifndef CONV_FIRST
#define CONV_FIRST 0
#endif
#ifndef PROBE_DNK
#define PROBE_DNK(r) DFF
#endif
#ifndef PROBE_GUK
#define PROBE_GUK(r) DM
#endif
#if MK_PER_PHASE
#define PH_END do { ++pid; } while (0)
#else
#define PH_END do { { XcdBarrier bar_; bar_.bar = (unsigned*)(a.ws + WS_CTL) + CW_BAR; bar_.x = xb_xcc_id(); bar_.st = (volatile LAS unsigned*)(lds + MISC_OFF) + 8; xcd_barrier(bar_); } } while (0)
#endif
#define GEMM(EpiT, E, Aptr, Bptr, Mv, Nv, Kv, cid) do { pg8::Gemm g_{(const pg8::bf16_t*)(Aptr), (const pg8::bf16_t*)(Bptr), (Mv), (Nv), (Kv)}; pg8::StaticOrder S_; S_.init((Mv), (Nv), G, (cid)); \
        pg8::gemm_phase<EpiT, pg8::StaticOrder, GEMM_ALIGN, GEMM_SP2>(lds, g_, S_, E); } while (0)

    if (PH_ON && SITE(0)) for (int rep_ = 0; rep_ < NREP(0); ++rep_) { WSO; TIDS;
        const float* xin = a.in[0];
        for (int mrow = gw; mrow < MTOK; mrow += NGW) {
            const GAS f32x4* xr = (const GAS f32x4*)(xin + (size_t)mrow * DM) + lane;
            GAS u32x2* xbo = (GAS u32x2*)(xb + (size_t)mrow * DM) + lane; float s = 0.f;
#pragma unroll
            for (int j = 0; j < 4; ++j) { const f32x4 v = xr[64 * j]; s += (v.x * v.x + v.y * v.y) + (v.z * v.z + v.w * v.w); xbo[64 * j] = (u32x2){pk2(v.x, v.y), pk2(v.z, v.w)}; }
            s = wave_sum(s);
            if (lane < 4) ssq[(size_t)mrow * 4 + lane] = (lane == 0) ? s : 0.f;
        }
        const float* memin = a.in[1];
        for (int mrow = gw; mrow < MROWS; mrow += NGW) {
            const GAS f32x4* xr = (const GAS f32x4*)(memin + (size_t)mrow * DM) + lane; GAS u32x2* xbo = (GAS u32x2*)(memb + (size_t)mrow * DM) + lane; float s = 0.f;
#pragma unroll
            for (int j = 0; j < 4; ++j) { const f32x4 v = xr[64 * j]; s += (v.x * v.x + v.y * v.y) + (v.z * v.z + v.w * v.w); xbo[64 * j] = (u32x2){pk2(v.x, v.y), pk2(v.z, v.w)}; }
            s = wave_sum(s);
            if (lane == 0) memssq[mrow] = s;
        }
        const int* pos = (const int*)a.in[2];
        for (int idx = bx * NTHREADS + tid; idx < MTOK * 32; idx += G * NTHREADS) {
            const int row = idx >> 5, i = idx & 31;
            double f = 1.0; for (int k = 0; k < i; ++k) f *= 0.74989420933245582730;
            const float ang = (float)pos[row] * (float)f;
            const double ad = (double)ang; const double kk = __builtin_rint(ad * 0.15915494309189533577); const float red = (float)(ad - kk * 6.283185307179586476925);
            cosT[idx] = __builtin_amdgcn_cosf(red * 0.15915494309189535f); sinT[idx] = __builtin_amdgcn_sinf(red * 0.15915494309189535f);
        }
        conv_layer(a, 0, (LAS float*)(lds + wave * 16384), gw, NGW, lane);
#if defined(PROBE_CONV0)
        for (int pc_ = 0; pc_ < PROBE_CONV0; ++pc_) conv_layer(a, 0, (LAS float*)(lds + wave * 16384), gw, NGW, lane);
#endif
    }
    PH_END;

#define CONV_SLOTS (432 * NWAVES)
#define CONV_FILL(first_wg, slot0) do { if (l + 1 < DEPTH && bx >= (first_wg)) { TIDS; conv_layer(a, l + 1, (LAS float*)(lds + wave * 16384), (slot0) + (bx - (first_wg)) * NWAVES + wave, CONV_SLOTS, lane); } if (PROBE_DUP >= 0) __syncthreads(); } while (0)
    for (int hs = 0; hs < 2 * DEPTH; ++hs) {
        const int l = hs >> 1, second = hs & 1;
        if (PH_ON && SITE(2)) for (int rep_ = 0; rep_ < NREP(2); ++rep_) { WSO;
#if defined(PROBE_EPITRIV)
            EpiGU E{act, ssq, rep_ == 0 ? 1 : 0};
#else
            EpiGU E{act, ssq};
#endif
#if CONV_FIRST
            CONV_FILL(128, second ? 304 * NWAVES : 0); if (l + 1 < DEPTH && bx >= 128) __syncthreads();
            GEMM(EpiGU, E, xb, wl + (second ? W_GU2 : W_GU1), MTOK, NGU, PROBE_GUK(rep_), bx); }
#else
            GEMM(EpiGU, E, xb, wl + (second ? W_GU2 : W_GU1), MTOK, NGU, PROBE_GUK(rep_), bx); CONV_FILL(128, second ? 304 * NWAVES : 0); }
#endif
        PH_END;
        if (PH_ON && SITE(3)) for (int rep_ = 0; rep_ < NREP(3); ++rep_) { WSO; EpiRES E{xb, ssq, rep_ ? 0.f : 0.5f, (LAS float*)(lds + LDS_HIST)}; GEMM(EpiRES, E, act, wl + (second ? W_DN2 : W_DN1), MTOK, DM, PROBE_DNK(rep_), bx); }
        PH_END;
        if (second) continue;

        if (PH_ON && SITE(4)) for (int rep_ = 0; rep_ < NREP(4); ++rep_) { WSO; EpiIN E{qkn, qkr, vt, gates, lfb, widx, ssq, cosT, sinT, a.in[8] + l * 6, (unsigned*)(a.ws + WS_CTL) + CW_KINF + l * 32}; GEMM(EpiIN, E, xb, wl + W_IN, MTOK, NIN, DM, bx); CONV_FILL(192, 128 * NWAVES); }
        PH_END;
        if (PH_ON && SITE(5)) for (int rep_ = 0; rep_ < NREP(5); ++rep_) { WSO; TIDS;
            constexpr int NIDX = MTOK / 8;
            const bf16* QI_ = qkr + (size_t)10 * MTOK * 64; const bf16* KI_ = qkr + (size_t)18 * MTOK * 64;
#define IDX_AT(r_, b_, t_) do { const int c_ = ((r_) & 1) ? (G - 1 - bx) : bx; const int pi_ = (r_) * G + c_; b_ = pi_ % 4; t_ = 8 * ((NIDX / 4 - 1) - pi_ / 4); } while (0)
            IdxPre P_;
            { int b0_, t0_; IDX_AT(0, b0_, t0_); idx_preload(P_, QI_, KI_, widx, b0_, t0_); }
            for (int r = 0; r < NIDX / G; ++r) {
                int b, t0, nb, nt0; IDX_AT(r, b, t0); IDX_AT(r + 1, nb, nt0);
#if defined(PROBE_IDX)
                idx_unit(lds, P_, QI_, KI_, widx, maskb, b, t0, r + 1 < NIDX / G, nb, nt0, rep_ == 0 ? 3 : PROBE_IDX);
#else
                idx_unit(lds, P_, QI_, KI_, widx, maskb, b, t0, r + 1 < NIDX / G, nb, nt0);
#endif
            }
#undef IDX_AT
        }
        PH_END;
        if (PH_ON && SITE(6)) for (int rep_ = 0; rep_ < NREP(6); ++rep_) { WSO; TIDS;
            volatile LAS int* qslot = (volatile LAS int*)(lds + MISC_OFF) + 16;
            unsigned* qhead = (unsigned*)(a.ws + WS_CTL) + CW_QUEUE + 64 * (4 * l + rep_);
            const int ntot = MIX_NUNITS;
            unsigned nxt_ = 0u;
            if (QUEUE_AHEAD && tid == 0) nxt_ = __hip_atomic_fetch_add(qhead, 1u, RLX_AGENT);
            for (;;) {
                if (!QUEUE_AHEAD && tid == 0) nxt_ = __hip_atomic_fetch_add(qhead, 1u, RLX_AGENT);
                if (tid == 0) qslot[0] = (int)nxt_;
                __syncthreads();
                const int p = qslot[0];
                __syncthreads();
                if (p >= ntot) break;
                if (QUEUE_AHEAD && tid == 0) nxt_ = __hip_atomic_fetch_add(qhead, 1u, RLX_AGENT);
                int lv = 0;
                while (p >= (int)MIX_LV_START[lv + 1]) ++lv;
                const int type = MIX_LV_TYPE[lv], qb = MIX_LV_QB[lv], j = p - (int)MIX_LV_START[lv];
#if defined(MIX_ONLY)
                if (type != MIX_ONLY) continue;
#endif
#if defined(PROBE_TYPE)
                if (rep_ == 1 && type != PROBE_TYPE) continue;
#endif
                if (type == 0) {
                    const int b = j / 6, h = j % 6;
                    LAS float* cl2 = (LAS float*)(lds + 65536);
                    {
                        int tid = threadIdx.x; asm volatile("" : "+v"(tid)); const int lane = tid & 63, wave = __builtin_amdgcn_readfirstlane(tid >> 6);
                        const GAS f32x4* src = (const GAS f32x4*)(lfb + (size_t)h * MTOK + (size_t)b * SEQ + 8 * tid);
                        const f32x4 v0 = src[0], v1 = src[1];
                        float e[8]; e[0] = v0.x; e[1] = e[0] + v0.y; e[2] = e[1] + v0.z; e[3] = e[2] + v0.w; e[4] = e[3] + v1.x; e[5] = e[4] + v1.y; e[6] = e[5] + v1.z; e[7] = e[6] + v1.w;
                        float inc = e[7];
#pragma unroll
                        for (int o = 1; o < 64; o <<= 1) { const float v = __shfl_up(inc, o); if (lane >= o) inc += v; }
                        LAS float* wsum = (LAS float*)(lds + 65536 + 16384);
                        if (lane == 63) wsum[wave] = inc;
                        __syncthreads();
                        float off = inc - e[7];
                        for (int w = 0; w < wave; ++w) off += wsum[w];
#pragma unroll
                        for (int jj = 0; jj < 8; ++jj) cl2[8 * tid + jj] = -(off + e[jj]) * LOG2E;
                        __syncthreads();
                    }
                    const size_t hb = (size_t)b * SEQ * 64;
                    flash_unit<64, 0>(lds, qkn + (size_t)h * MTOK * 64 + hb, qkn + (size_t)(6 + h) * MTOK * 64 + hb, vt + (size_t)(h * 4 + b) * 64 * SEQ, SEQ,
                                      oatt + (size_t)b * SEQ * 384 + h * 64, 384, qb * 256, 4 * (qb + 1), nullptr, cl2,
                                      __uint_as_float(__hip_atomic_load((unsigned*)(a.ws + WS_CTL) + CW_KINF + l * 32 + b * 8 + h, RLX_AGENT)));
                } else {
                    const int b = j / 5, h = j % 5;
                    const size_t hb = (size_t)b * SEQ * 64;
                    if (type == 1) {
                        flash_unit<64, 1>(lds, qkr + (size_t)h * MTOK * 64 + hb, qkr + (size_t)(5 + h) * MTOK * 64 + hb, vt + (size_t)((6 + h) * 4 + b) * 64 * SEQ, SEQ,
                                          oatt + (size_t)MTOK * 384 + (size_t)b * SEQ * 384 + h * 64, 384, qb * 256, 4 * (qb + 1), maskb + (size_t)b * SEQ * 64, nullptr);
                    } else {
                        sb_unit(lds, qkn + (size_t)(12 + h) * MTOK * 64 + hb, qkn + (size_t)(17 + h) * MTOK * 64 + hb, vt + (size_t)((11 + h) * 4 + b) * 64 * SEQ,
                                oatt + (size_t)2 * MTOK * 384 + (size_t)b * SEQ * 384 + h * 64, qb * 256);
                    }
                    if (h == 4) {
                        int t2 = threadIdx.x; asm volatile("" : "+v"(t2));
                        bf16* ob = oatt + (size_t)type * MTOK * 384 + ((size_t)b * SEQ + qb * 256 + (t2 >> 1)) * 384 + 320 + 32 * (t2 & 1);
#pragma unroll
                        for (int jj = 0; jj < 4; ++jj) *(GAS u32x4*)(ob + 8 * jj) = (u32x4){0u, 0u, 0u, 0u};
                    }
                }
            }
        }
        PH_END;
        if (PH_ON && SITE(7)) for (int rep_ = 0; rep_ < NREP(7); ++rep_) { WSO;
            EpiBR E{gates, mf, mb}; pg8::Gemm g_{(const pg8::bf16_t*)oatt, (const pg8::bf16_t*)(wl + W_BR), 3 * MTOK, 3 * DM, 384}; BranchOrder S_; S_.S.init(MTOK, DM, G, bx);
            pg8::gemm_phase<EpiBR, BranchOrder, GEMM_ALIGN, GEMM_SP2>(lds, g_, S_, E);
        }
        PH_END;
        if (PH_ON && SITE(8)) for (int rep_ = 0; rep_ < NREP(8); ++rep_) { WSO; EpiRES E{xb, ssq, rep_ ? 0.f : 1.0f, (LAS float*)(lds + LDS_HIST)}; GEMM(EpiRES, E, mb, wl + W_OUT, MTOK, DM, DM, bx); }
        PH_END;
        if (PH_ON && SITE(9)) for (int rep_ = 0; rep_ < NREP(9); ++rep_) { WSO;
            { EpiCQ E{caq, ssq}; GEMM(EpiCQ, E, xb, wl + W_CQ, MTOK, 512, DM, bx); }
            { EpiCKV E{mk, mvt, memssq}; GEMM(EpiCKV, E, memb, wl + W_CKV, MROWS, DM, DM, (bx + G - 128) % G); }
            CONV_FILL(144, 192 * NWAVES);
        }
        PH_END;
        if (PH_ON && SITE(10)) for (int rep_ = 0; rep_ < NREP(10); ++rep_) { WSO;
            for (int p = bx; p < 256; p += G) {
                const int b = p >> 6, h = (p >> 4) & 3, qb = p & 15;
                flash_unit<128, 2>(lds, caq + ((size_t)h * MTOK + (size_t)b * SEQ) * 128, mk + (size_t)(b * 4 + h) * 256 * 128, mvt + (size_t)(b * 4 + h) * 128 * 256, 256,
                                   cao + (size_t)b * SEQ * 512 + h * 128, 512, qb * 256, 4, nullptr, nullptr);
            }
        }
        PH_END;
#if defined(PROBE_BAR)
        for (int eb_ = 0; eb_ < PROBE_BAR; ++eb_) PH_END;
#endif
        if (PH_ON && SITE(11)) for (int rep_ = 0; rep_ < NREP(11); ++rep_) { WSO; EpiRES E{xb, ssq, rep_ ? 0.f : 1.0f, (LAS float*)(lds + LDS_HIST)}; GEMM(EpiRES, E, cao, wl + W_CO, MTOK, DM, 512, bx); }
        PH_END;
    }
    if (PH_ON && SITE(12)) for (int rep_ = 0; rep_ < NREP(12); ++rep_) { WSO; TIDS;
        const float* gfin = a.in[21];
        f32x4 gv[4];
#pragma unroll
        for (int j = 0; j < 4; ++j) gv[j] = ((const GAS f32x4*)gfin)[lane + 64 * j];
        for (int mrow = gw; mrow < MTOK; mrow += NGW) {
            const float r = rstd16(ssq, mrow);
            const GAS u32x2* xi = (const GAS u32x2*)(xb + (size_t)mrow * DM) + lane;
            GAS f32x4* xo = (GAS f32x4*)(x + (size_t)mrow * DM) + lane;
#pragma unroll
            for (int j = 0; j < 4; ++j) { const u32x2 w = xi[64 * j]; f32x4 v = {__uint_as_float(w.x << 16), __uint_as_float(w.x & 0xffff0000u), __uint_as_float(w.y << 16), __uint_as_float(w.y & 0xffff0000u)}; v = v * r * gv[j]; xo[64 * j] = v; }
        }
    }
#undef PH_ON
#undef PH_END
#undef GEMM
}

extern "C" void kernel_launch(void* const* d_in, const int* in_sizes, int n_in, void* d_out, int out_size, void* d_ws, size_t ws_size, hipStream_t stream) {
    static int grid = 0;
    if (grid == 0) {
        if (n_in != 22 || out_size != MTOK * DM || ws_size < WS_END) { fprintf(stderr, "kernel_launch: unexpected shapes (n_in %d, out %d, ws %zu < %zu); nothing launched\n", n_in, out_size, ws_size, (size_t)WS_END); grid = -1; return; }
        int dev = 0, cus = 0, per_cu = 0;
        if (hipGetDevice(&dev) != hipSuccess || hipDeviceGetAttribute(&cus, hipDeviceAttributeMultiprocessorCount, dev) != hipSuccess) { grid = -1; return; }
        if (hipFuncSetAttribute((const void*)mk_fwd, hipFuncAttributeMaxDynamicSharedMemorySize, LDS_BYTES) != hipSuccess) { fprintf(stderr, "kernel_launch: hipFuncSetAttribute failed\n"); grid = -1; return; }
        if (hipOccupancyMaxActiveBlocksPerMultiprocessor(&per_cu, (const void*)mk_fwd, NTHREADS, LDS_BYTES) != hipSuccess || per_cu < 1) { fprintf(stderr, "kernel_launch: occupancy query reports %d\n", per_cu); }
        (void)hipGetLastError();
        if (cus < 256) { fprintf(stderr, "kernel_launch: %d CUs < 256; nothing launched\n", cus); grid = -1; return; }
        grid = 256;
    }
    if (grid < 0) return;
    (void)in_sizes;
    if (hipMemsetAsync((char*)d_ws + WS_CTL, 0, CTL_ZERO_BYTES, stream) != hipSuccess) return;
    Args a{};
    for (int i = 0; i < 22; ++i) a.in[i] = (const float*)d_in[i];
    a.out = (float*)d_out; a.ws = (unsigned char*)d_ws;
#if MK_PER_PHASE
    for (int p = 0; p < NPHASES; ++p) { a.ph_lo = p; a.ph_hi = p + 1; hipLaunchKernelGGL(mk_fwd, dim3(grid), dim3(NTHREADS), LDS_BYTES, stream, a); }
#else
    a.ph_lo = 0; a.ph_hi = NPHASES;
    hipLaunchKernelGGL(mk_fwd, dim3(grid), dim3(NTHREADS), LDS_BYTES, stream, a);
#endif
}
```

```cpp
#define MIX_ORDER 1
#include <hip/hip_runtime.h>
#include <cstdio>
#include <cstdint>
namespace pg8 {
#define PG8_LAS __attribute__((address_space(3)))
typedef unsigned short bf16_t;
typedef short bf16x8 __attribute__((ext_vector_type(8)));
typedef float f32x4 __attribute__((ext_vector_type(4)));
typedef unsigned u32x4 __attribute__((ext_vector_type(4)));
constexpr int BM = 256, BK = 64, HALF = 128, HTB = HALF * BK * 2  , STAGE_BYTES = 8 * HTB, NXCD = 8, WGM = 8;

__host__ __device__ __forceinline__ int lds_byte(int r, int c) { const int st = (r >> 4) * 2 + (c >> 5), rr = r & 15, cc = c & 31, ob = rr * 64 + cc * 2; return st * 1024 + (ob ^ (((ob >> 9) & 1) << 5)); }
__host__ __device__ __forceinline__ void stage_rc(int b, int& R, int& C) { const int st = b / 1024, sb = b % 1024, swz = sb ^ (((sb >> 9) & 1) << 5); R = (st >> 1) * 16 + swz / 64; C = (st & 1) * 32 + (swz % 64) / 2; }
__host__ __device__ __forceinline__ int perm32(int rho) { const int n = rho >> 4, i = rho & 15; return 8 * (i >> 2) + 4 * n + (i & 3); }

struct Unit { int pm, pn; };
struct Gemm { const bf16_t* A; const bf16_t* Bt; int M, N, K; };

struct StaticOrder {
    int nM, nN, nwg, G, c;
    __host__ __device__ void init(int M, int N, int G_, int c_) { nM = M / BM; nN = N / BM; nwg = nM * nN; G = G_; c = c_; }
    __host__ __device__ bool next(int i, Unit& u) const {
        const long L = (long)i * G + c; if (L >= nwg) return false;
        int wgid = (int)L; { const int q = nwg / NXCD, r = nwg % NXCD, xcd = wgid % NXCD, off = wgid / NXCD; wgid = (xcd < r ? xcd * (q + 1) : r * (q + 1) + (xcd - r) * q) + off; }
        const int nig = WGM * nN, gid = wgid / nig, fm = gid * WGM, gsz = (nM - fm) < WGM ? (nM - fm) : WGM;
        u.pm = fm + ((wgid % nig) % gsz); u.pn = (wgid % nig) / gsz; return true;
    }
    __device__ __forceinline__ void a_ready(const Unit&) const {}
    __device__ __forceinline__ void done(const Unit&) const {}
};

__device__ __forceinline__ unsigned cvt_pk_bf16(float lo, float hi) { unsigned r; asm volatile("v_cvt_pk_bf16_f32 %0, %1, %2" : "=v"(r) : "v"(lo), "v"(hi)); return r; }
typedef float f32x2 __attribute__((ext_vector_type(2)));

template <class Epi, class Sched, bool ALIGN_EPI = false, bool SP2 = false>
__device__ __forceinline__ void gemm_phase(PG8_LAS unsigned char* lds, const Gemm g, const Sched& S, const Epi& E) {
    int tid_ = threadIdx.x; asm volatile("" : "+v"(tid_));
    const int tid = tid_, wid = __builtin_amdgcn_readfirstlane(tid >> 6), lane = tid & 63, wr = wid >> 2, wc = wid & 3, fr = lane & 15, fq = lane >> 4;
    const int K = g.K, nt = K / BK;
    unsigned voffA[2], voffB[2];
#pragma unroll
    for (int i = 0; i < 2; ++i) { int R, C; stage_rc(tid * 16 + i * 8192, R, C); const int Rb = Epi::PERM ? ((R & ~31) + perm32(R & 31)) : R;
        voffA[i] = (unsigned)(R * K + C) * 2u; voffB[i] = (unsigned)(Rb * K + C) * 2u; }
    const size_t kstep = (size_t)(BK * 2);
    const size_t hstep = (size_t)HALF * K * 2;
    const size_t tstep = 2 * hstep;
    const unsigned ldsw = (unsigned)wid * 1024u;
    const int aoff = lds_byte(wr * 64 + fr, fq * 8), boff = lds_byte(wc * 32 + fr, fq * 8);
#define PG8_SA(b, h) (((b) * 2 + (h)) * HTB)
#define PG8_SB(b, h) ((4 + (b) * 2 + (h)) * HTB)
#define PG8_STAGE(bufoff, gbase, voff) do { _Pragma("unroll") for (int _i = 0; _i < 2; ++_i) \
        __builtin_amdgcn_global_load_lds((const unsigned*)((const char*)(gbase) + (voff)[_i]), (PG8_LAS unsigned*)(lds + (bufoff) + ldsw + _i * 8192), 16, 0, 0); } while (0)
#define PG8_LDA(dst, b, h) do { _Pragma("unroll") for (int m = 0; m < 4; ++m) _Pragma("unroll") for (int k = 0; k < 2; ++k) dst[m][k] = *(const PG8_LAS bf16x8*)(lds + PG8_SA(b, h) + aoff + m * 2048 + k * 1024); } while (0)
#define PG8_LDB(dst, b, h) do { _Pragma("unroll") for (int n = 0; n < 2; ++n) _Pragma("unroll") for (int k = 0; k < 2; ++k) dst[n][k] = *(const PG8_LAS bf16x8*)(lds + PG8_SB(b, h) + boff + n * 2048 + k * 1024); } while (0)
#define PG8_MMA(ai, bj, At, Bt) do { __builtin_amdgcn_s_setprio(1); _Pragma("unroll") for (int m = 0; m < 4; ++m) _Pragma("unroll") for (int n = 0; n < 2; ++n) _Pragma("unroll") for (int k = 0; k < 2; ++k) \
        acc[ai][bj][m][n] = __builtin_amdgcn_mfma_f32_16x16x32_bf16(Bt[n][k], At[m][k], acc[ai][bj][m][n], 0, 0, 0); __builtin_amdgcn_s_setprio(0); } while (0)
#define PG8_WAIT_V(n) asm volatile("s_waitcnt vmcnt(" #n ")" ::: "memory")
#define PG8_WAIT_L(n) asm volatile("s_waitcnt lgkmcnt(" #n ")" ::: "memory")
#define PG8_BAR __builtin_amdgcn_s_barrier()
#define PG8_SCHED __builtin_amdgcn_sched_barrier(0)
    Unit cur, nxt; int ui = 0;
    if (!S.next(0, cur)) return;
    f32x4 acc[2][2][4][2];
#pragma unroll
    for (int a = 0; a < 2; ++a)
#pragma unroll
        for (int b = 0; b < 2; ++b)
#pragma unroll
            for (int m = 0; m < 4; ++m)
#pragma unroll
                for (int n = 0; n < 2; ++n) acc[a][b][m][n] = (f32x4){0.f, 0.f, 0.f, 0.f};
    bf16x8 At[4][2], B0[2][2], B1[2][2];
    const char* cA = (const char*)g.A + (size_t)cur.pm * tstep; const char* cB = (const char*)g.Bt + (size_t)cur.pn * tstep;
    S.a_ready(cur);
    if constexpr (SP2) {
        PG8_STAGE(PG8_SB(0, 0), cB, voffB); PG8_STAGE(PG8_SB(0, 1), cB + hstep, voffB); PG8_STAGE(PG8_SA(0, 0), cA, voffA); PG8_STAGE(PG8_SA(0, 1), cA + hstep, voffA);
        if (wr == 1) PG8_BAR;
        PG8_WAIT_V(2); PG8_BAR;
        PG8_STAGE(PG8_SB(1, 0), cB + kstep, voffB); PG8_STAGE(PG8_SA(1, 0), cA + kstep, voffA); PG8_STAGE(PG8_SB(1, 1), cB + hstep + kstep, voffB);
        PG8_WAIT_V(6); PG8_BAR;
    } else {
        PG8_STAGE(PG8_SB(0, 0), cB, voffB); PG8_STAGE(PG8_SA(0, 0), cA, voffA); PG8_STAGE(PG8_SB(0, 1), cB + hstep, voffB); PG8_STAGE(PG8_SA(0, 1), cA + hstep, voffA);
        if (wr == 1) PG8_BAR;
        PG8_WAIT_V(4); PG8_BAR;
        PG8_STAGE(PG8_SB(1, 0), cB + kstep, voffB); PG8_STAGE(PG8_SA(1, 0), cA + kstep, voffA); PG8_STAGE(PG8_SB(1, 1), cB + hstep + kstep, voffB);
        PG8_WAIT_V(6); PG8_BAR;
    }
    for (;;) {
        const bool has_next = S.next(ui + 1, nxt);
        const char* nA = has_next ? (const char*)g.A + (size_t)nxt.pm * tstep : cA; const char* nB = has_next ? (const char*)g.Bt + (size_t)nxt.pn * tstep : cB;
#pragma unroll 1
        for (int t = 0; t < nt; t += 2) {
            const bool last = (t == nt - 2);
            const char* a1 = cA + (size_t)(t + 1) * kstep;
            const char* a2 = last ? nA : cA + (size_t)(t + 2) * kstep; const char* b2 = last ? nB : cB + (size_t)(t + 2) * kstep;
            const char* a3 = a2 + kstep; const char* b3 = b2 + kstep;
            if (last && has_next) S.a_ready(nxt);
            if constexpr (SP2) {
            PG8_LDB(B0, 0, 0); PG8_LDB(B1, 0, 1); PG8_SCHED; PG8_LDA(At, 0, 0); PG8_STAGE(PG8_SA(1, 1), a1 + hstep, voffA);
            PG8_WAIT_V(8); PG8_WAIT_L(0); PG8_BAR; PG8_MMA(0, 0, At, B0); PG8_MMA(0, 1, At, B1); PG8_BAR; PG8_SCHED;
            PG8_LDA(At, 0, 1); PG8_STAGE(PG8_SB(0, 0), b2, voffB); PG8_STAGE(PG8_SB(0, 1), b2 + hstep, voffB); PG8_STAGE(PG8_SA(0, 0), a2, voffA);
            PG8_WAIT_V(8); PG8_WAIT_L(0); PG8_BAR; PG8_MMA(1, 0, At, B0); PG8_MMA(1, 1, At, B1); PG8_BAR; PG8_SCHED;
            PG8_LDB(B0, 1, 0); PG8_LDB(B1, 1, 1); PG8_SCHED; PG8_LDA(At, 1, 0); PG8_STAGE(PG8_SA(0, 1), a2 + hstep, voffA);
            PG8_WAIT_V(8); PG8_WAIT_L(0); PG8_BAR; PG8_MMA(0, 0, At, B0); PG8_MMA(0, 1, At, B1); PG8_BAR; PG8_SCHED;
            PG8_LDA(At, 1, 1); PG8_STAGE(PG8_SB(1, 0), b3, voffB); PG8_STAGE(PG8_SB(1, 1), b3 + hstep, voffB); PG8_STAGE(PG8_SA(1, 0), a3, voffA);
            PG8_WAIT_V(8); PG8_WAIT_L(0); PG8_BAR; PG8_MMA(1, 0, At, B0); PG8_MMA(1, 1, At, B1); PG8_BAR; PG8_SCHED;
            } else {
            PG8_LDB(B0, 0, 0); PG8_SCHED; PG8_LDA(At, 0, 0); PG8_STAGE(PG8_SA(1, 1), a1 + hstep, voffA);
            PG8_WAIT_L(8); PG8_BAR; PG8_WAIT_L(0); PG8_MMA(0, 0, At, B0); PG8_BAR; PG8_SCHED;
            PG8_LDB(B1, 0, 1); PG8_STAGE(PG8_SB(0, 0), b2, voffB);
            PG8_BAR; PG8_WAIT_L(0); PG8_MMA(0, 1, At, B1); PG8_BAR;
            PG8_LDA(At, 0, 1); PG8_STAGE(PG8_SA(0, 0), a2, voffA);
            PG8_BAR; PG8_WAIT_L(0); PG8_MMA(1, 0, At, B0); PG8_BAR; PG8_SCHED;
            PG8_STAGE(PG8_SB(0, 1), b2 + hstep, voffB);
            PG8_WAIT_V(6); PG8_BAR; PG8_MMA(1, 1, At, B1); PG8_BAR;
            PG8_LDB(B0, 1, 0); PG8_SCHED; PG8_LDA(At, 1, 0); PG8_STAGE(PG8_SA(0, 1), a2 + hstep, voffA);
            PG8_WAIT_L(8); PG8_BAR; PG8_WAIT_L(0); PG8_MMA(0, 0, At, B0); PG8_BAR; PG8_SCHED;
            PG8_LDB(B1, 1, 1); PG8_STAGE(PG8_SB(1, 0), b3, voffB);
            PG8_BAR; PG8_WAIT_L(0); PG8_MMA(0, 1, At, B1); PG8_BAR;
            PG8_LDA(At, 1, 1); PG8_STAGE(PG8_SA(1, 0), a3, voffA);
            PG8_BAR; PG8_WAIT_L(0); PG8_MMA(1, 0, At, B0); PG8_BAR; PG8_SCHED;
            PG8_STAGE(PG8_SB(1, 1), b3 + hstep, voffB);
            PG8_WAIT_V(6); PG8_BAR; PG8_MMA(1, 1, At, B1); PG8_BAR;
            }
        }
        if constexpr (ALIGN_EPI) { if (wr == 0) PG8_BAR; }
        if constexpr (!Epi::AFTER_DRAIN) { E(acc, cur, wr, wc, fr, fq); S.done(cur); }
        if (!has_next) break;
#pragma unroll
        for (int a = 0; a < 2; ++a)
#pragma unroll
            for (int b = 0; b < 2; ++b)
#pragma unroll
                for (int m = 0; m < 4; ++m)
#pragma unroll
                    for (int n = 0; n < 2; ++n) acc[a][b][m][n] = (f32x4){0.f, 0.f, 0.f, 0.f};
        cur = nxt; cA = nA; cB = nB; ++ui;
        if constexpr (ALIGN_EPI) { if (wr == 1) PG8_BAR; }
    }
    PG8_WAIT_V(0);
    if constexpr (!ALIGN_EPI) { if (wr == 0) PG8_BAR; }
    PG8_BAR;
    if constexpr (Epi::AFTER_DRAIN) { E.fused(acc, cur, wr, wc, fr, fq, lds, wid, lane); S.done(cur); }
#undef PG8_SA
#undef PG8_SB
#undef PG8_STAGE
#undef PG8_LDA
#undef PG8_LDB
#undef PG8_MMA
#undef PG8_WAIT_V
#undef PG8_WAIT_L
#undef PG8_BAR
#undef PG8_SCHED
}
}

#define GAS __attribute__((address_space(1)))
#define LAS __attribute__((address_space(3)))
typedef unsigned short bf16;
typedef short bf16x8 __attribute__((ext_vector_type(8)));
typedef float f32x4 __attribute__((ext_vector_type(4)));
typedef float f32x2 __attribute__((ext_vector_type(2)));
typedef float f32x16 __attribute__((ext_vector_type(16)));
typedef unsigned u32x4 __attribute__((ext_vector_type(4)));
typedef unsigned u32x2 __attribute__((ext_vector_type(2)));
typedef __bf16 bf16x2_t __attribute__((ext_vector_type(2)));

#ifndef MK_PER_PHASE
#define MK_PER_PHASE 0
#endif

constexpr int BATCH = 4, SEQ = 4096, DM = 1024, DEPTH = 4, MTOK = BATCH * SEQ;
constexpr int DFF = 2816, NGU = 2 * DFF, DIN = 6734, NIN = 6912;
constexpr int NMEM = 256, MROWS = BATCH * NMEM;
constexpr float EPS = 1e-6f;
constexpr float LOG2E = 1.4426950408889634f, LN2 = 0.6931471805599453f;
constexpr float C2_64 = 0.125f * LOG2E;
constexpr float C2_128 = 0.08838834764831845f * LOG2E;
constexpr float WIDX_SCALE = 0.35355339059327373f * 0.125f;
constexpr int NTHREADS = 512, NWAVES = 8;

constexpr size_t MiB = (size_t)1 << 20;
constexpr size_t WS_CTL = 0, CTL_ZERO_BYTES = 1 * MiB;
constexpr size_t WS_COS = 1 * MiB, WS_SIN = 3 * MiB;
constexpr size_t WS_SSQ = 5 * MiB;
constexpr size_t WS_MEMB = 6 * MiB;
constexpr size_t WS_MEMSSQ = 8 * MiB;
constexpr size_t WS_LF = 9 * MiB;
constexpr size_t WS_WIDX = 10 * MiB;
constexpr size_t WS_MK = 11 * MiB, WS_MVT = 12 * MiB;
constexpr size_t WS_XB = 16 * MiB;
constexpr size_t WS_W = 48 * MiB;
constexpr size_t W_GU1 = 0, W_DN1 = W_GU1 + (size_t)NGU * DM * 2, W_IN = W_DN1 + (size_t)DM * DFF * 2, W_BR = W_IN + (size_t)NIN * DM * 2,
                 W_OUT = W_BR + (size_t)3 * DM * 384 * 2, W_CQ = W_OUT + (size_t)DM * DM * 2, W_CKV = W_CQ + (size_t)512 * DM * 2,
                 W_CO = W_CKV + (size_t)DM * DM * 2, W_GU2 = W_CO + (size_t)DM * 512 * 2, W_DN2 = W_GU2 + (size_t)NGU * DM * 2, W_END = W_DN2 + (size_t)DM * DFF * 2;
static_assert(W_END <= 56 * MiB, "weights region");
constexpr size_t WS_W2 = 104 * MiB;
constexpr size_t WS_R = 160 * MiB;
constexpr size_t WS_ACT = WS_R;
constexpr size_t WS_QKN = WS_R;
constexpr size_t WS_QKR = WS_R + 48 * MiB;
constexpr size_t WS_VT = WS_R + 88 * MiB;
constexpr size_t WS_GATES = WS_R + 120 * MiB;
constexpr size_t WS_MASK = WS_R + 216 * MiB;
constexpr size_t WS_OATT = WS_R + 224 * MiB;
constexpr size_t WS_MF = WS_R;
constexpr size_t WS_MB = WS_R + 64 * MiB;
constexpr size_t WS_CAQ = WS_R;
constexpr size_t WS_CAO = WS_R + 16 * MiB;
constexpr size_t WS_END = WS_R + 260 * MiB;

constexpr int CW_BAR = 4096;
constexpr int CW_QUEUE = 16384;
constexpr int CW_KINF = 20480;
constexpr int LDS_HIST = 131072;
constexpr int MISC_OFF = 139264 + 64;
constexpr int LDS_BYTES = 147456;

#define RLX_AGENT __ATOMIC_RELAXED, __HIP_MEMORY_SCOPE_AGENT
__device__ __forceinline__ unsigned pk2(float lo, float hi) { f32x2 v = {lo, hi}; bf16x2_t b = __builtin_convertvector(v, bf16x2_t); return __builtin_bit_cast(unsigned, b); }
__device__ __forceinline__ float bf2f(unsigned short h) { return __uint_as_float(((unsigned)h) << 16); }
__device__ __forceinline__ float wave_sum(float v) {
#pragma unroll
    for (int o = 1; o < 64; o <<= 1) v += __shfl_xor(v, o);
    return v;
}
__device__ __forceinline__ float fexp2(float x) { return __builtin_amdgcn_exp2f(x); }
__device__ __forceinline__ float flog2(float x) { return __builtin_amdgcn_logf(x); }
__device__ __forceinline__ float frcp(float x) { return __builtin_amdgcn_rcpf(x); }
__device__ __forceinline__ int tperm(int t) { return (t & ~12) | ((t & 4) << 1) | ((t & 8) >> 1); }

#define XB_TMO      128
#define XB_XCNT(j)  (256  + 64 * (j))
#define XB_XSUB(j)  (1280 + 64 * (j))
#define XB_XGEN(j)  (2304 + 64 * (j))
#define XB_TOP      3328
#define XB_TOPGEN   3392
#define XCD_BAR_WORDS 3456
#define XB_SPIN_CAP (1u << 18)

__device__ __forceinline__ unsigned xb_ld(unsigned* p)              { return __hip_atomic_load(p, __ATOMIC_RELAXED, __HIP_MEMORY_SCOPE_AGENT); }
__device__ __forceinline__ unsigned xb_add(unsigned* p, unsigned v) { return __hip_atomic_fetch_add(p, v, __ATOMIC_RELAXED, __HIP_MEMORY_SCOPE_AGENT); }
__device__ __forceinline__ unsigned xb_xcc_id() { return (unsigned)__builtin_amdgcn_s_getreg((3 << 11) | 20) & 0xFu; }
#define XB_SPIN(cond, bar) do { unsigned _sp = 0; while (cond) { __builtin_amdgcn_s_sleep(1); \
    if ((++_sp & 255u) == 0u) { if (xb_ld(&(bar)[XB_TMO])) break; if (_sp > XB_SPIN_CAP) { atomicAdd(&(bar)[XB_TMO], 1u); break; } } } } while (0)

struct XcdBarrier {
    unsigned* bar; unsigned x;
    volatile LAS unsigned* st;
};

__device__ __forceinline__ XcdBarrier xcd_barrier_post(unsigned* bar, volatile LAS unsigned* st) {
    XcdBarrier b; b.bar = bar; b.x = xb_xcc_id(); b.st = st;
    if (threadIdx.x == 0) (void)xb_add(&bar[XB_XCNT(b.x)], 1u);
    return b;
}
__device__ __forceinline__ void xcd_barrier_complete(unsigned* bar, unsigned x, unsigned& nloc, unsigned& nx) {
    const unsigned G = gridDim.x * gridDim.y * gridDim.z;
    unsigned sum, cnt, mine, sp = 0u;
    for (;;) {
        sum = 0u; cnt = 0u; mine = 0u;
#pragma unroll
        for (unsigned j = 0; j < 16; ++j) { const unsigned c = xb_ld(&bar[XB_XCNT(j)]); sum += c; cnt += (c > 0u) ? 1u : 0u; mine = (j == x) ? c : mine; }
        if (sum == G) break;
        __builtin_amdgcn_s_sleep(1);
        if ((++sp & 255u) == 0u) { if (xb_ld(&bar[XB_TMO])) break; if (sp > XB_SPIN_CAP) { atomicAdd(&bar[XB_TMO], 1u); break; } }
    }
    nloc = mine > 0u ? mine : 1u; nx = cnt > 0u ? cnt : 1u;
}

__device__ __forceinline__ void xcd_barrier(const XcdBarrier& b) {
    asm volatile("s_waitcnt vmcnt(0)" ::: "memory");
    __syncthreads();
    if (threadIdx.x == 0) {
        unsigned* bar = b.bar;
        __builtin_amdgcn_s_waitcnt(0);
        unsigned nloc = b.st[0], nx = b.st[1];
        if (nloc == 0u) { xcd_barrier_complete(bar, b.x, nloc, nx); b.st[0] = nloc; b.st[1] = nx; }
        const unsigned old = xb_add(&bar[XB_XSUB(b.x)], 1u);
        const unsigned gen = old / nloc;
        if (old + 1u == (gen + 1u) * nloc) {
            __builtin_amdgcn_fence(__ATOMIC_RELEASE, "agent");
            asm volatile("s_waitcnt vmcnt(0)" ::: "memory");
            const unsigned og = xb_add(&bar[XB_TOP], 1u);
            const unsigned tg = og / nx;
            if (og + 1u == (tg + 1u) * nx) xb_add(&bar[XB_TOPGEN], 1u);
            else XB_SPIN(xb_ld(&bar[XB_TOPGEN]) == tg, bar);
            __builtin_amdgcn_fence(__ATOMIC_ACQUIRE, "agent");
            xb_add(&bar[XB_XGEN(b.x)], 1u);
            asm volatile("s_waitcnt vmcnt(0)" ::: "memory");
        } else {
            XB_SPIN(xb_ld(&bar[XB_XGEN(b.x)]) == gen, bar);
            __builtin_amdgcn_fence(__ATOMIC_ACQUIRE, "agent");
            asm volatile("s_waitcnt vmcnt(0)" ::: "memory");
        }
    }
    __syncthreads();
}
typedef const pg8::f32x4 (&AccRef)[2][2][4][2];
#define EPI_GROUP(rb, base) int rb = (base); asm volatile("" : "+v"(rb))

__device__ __forceinline__ void rstd16x4(const float* ssq, int rb, float (&r)[4]) {
    f32x4 p[4];
#pragma unroll
    for (int m = 0; m < 4; ++m) p[m] = *(const GAS f32x4*)(ssq + (size_t)(rb + 16 * m) * 4);
#pragma unroll
    for (int m = 0; m < 4; ++m) r[m] = __builtin_amdgcn_rsqf(((p[m].x + p[m].y) + (p[m].z + p[m].w)) * (1.0f / DM) + EPS);
}
__device__ __forceinline__ float rstd16(const float* ssq, int row) {
    const f32x4 a = *(const GAS f32x4*)(ssq + (size_t)row * 4);
    return __builtin_amdgcn_rsqf(((a.x + a.y) + (a.z + a.w)) * (1.0f / DM) + EPS);
}
__device__ __forceinline__ u32x4 pack8(const float* h) { u32x4 w; w.x = pk2(h[0], h[1]); w.y = pk2(h[2], h[3]); w.z = pk2(h[4], h[5]); w.w = pk2(h[6], h[7]); return w; }
__device__ __forceinline__ float sigmoidf_(float x) { return frcp(1.f + fexp2(-x * LOG2E)); }
__device__ __forceinline__ float logsigmoidf_(float z) { return fminf(z, 0.f) - LN2 * flog2(1.f + fexp2(-fabsf(z) * LOG2E)); }
__device__ __forceinline__ void unpack8(const u32x4 w, f32x4& lo, f32x4& hi) {
    lo.x = __uint_as_float(w.x << 16); lo.y = __uint_as_float(w.x & 0xffff0000u); lo.z = __uint_as_float(w.y << 16); lo.w = __uint_as_float(w.y & 0xffff0000u);
    hi.x = __uint_as_float(w.z << 16); hi.y = __uint_as_float(w.z & 0xffff0000u); hi.z = __uint_as_float(w.w << 16); hi.w = __uint_as_float(w.w & 0xffff0000u);
}

struct EpiGU {
    static constexpr bool PERM = true, AFTER_DRAIN = false;
    bf16* act; const float* ssq;
#if defined(PROBE_EPITRIV)
    int triv;
#endif
    __device__ __forceinline__ void operator()(AccRef acc, const pg8::Unit& u, int wr, int wc, int fr, int fq) const {
        const int row0 = u.pm * 256 + wr * 64 + fr, col = u.pn * 128 + wc * 32 + fq * 8;
#if defined(PROBE_EPITRIV)
        if (triv) {
#if PROBE_EPITRIV == 2
            return;
#endif
#pragma unroll
            for (int ai = 0; ai < 2; ++ai)
#pragma unroll
                for (int m = 0; m < 4; ++m) { float h[8];
#pragma unroll
                    for (int n = 0; n < 2; ++n)
#pragma unroll
                        for (int j = 0; j < 4; ++j) h[4 * n + j] = acc[ai][0][m][n][j] * acc[ai][1][m][n][j];
                    *(GAS u32x4*)(act + (size_t)(row0 + ai * 128 + 16 * m) * DFF + col) = pack8(h); }
            return;
        }
#endif
#pragma unroll
        for (int ai = 0; ai < 2; ++ai) {
            EPI_GROUP(rb, row0 + ai * 128); float r4[4]; rstd16x4(ssq, rb, r4);
#pragma unroll
            for (int m = 0; m < 4; ++m) {
                const float r = r4[m]; float h[8];
#pragma unroll
                for (int n = 0; n < 2; ++n)
#pragma unroll
                    for (int j = 0; j < 4; ++j) { const float g = acc[ai][0][m][n][j] * r, uu = acc[ai][1][m][n][j] * r; h[4 * n + j] = g * sigmoidf_(g) * uu; }
#if defined(GU_NT)
                __builtin_nontemporal_store(pack8(h), (GAS u32x4*)(act + (size_t)(rb + 16 * m) * DFF + col));
#else
                *(GAS u32x4*)(act + (size_t)(rb + 16 * m) * DFF + col) = pack8(h);
#endif
            }
        }
    }
};
struct EpiRES {
    static constexpr bool PERM = true, AFTER_DRAIN = false;
    bf16* xb; float* ssq; float scale; LAS float* red;
    __device__ __forceinline__ void operator()(AccRef acc, const pg8::Unit& u, int wr, int wc, int fr, int fq) const {
        const int row0 = u.pm * 256 + wr * 64 + fr, col0 = u.pn * 256 + wc * 32 + fq * 8;
#pragma unroll
        for (int ai = 0; ai < 2; ++ai) {
            EPI_GROUP(rb, row0 + ai * 128);
            u32x4 xv[4][2];
#pragma unroll
            for (int m = 0; m < 4; ++m)
#pragma unroll
                for (int bj = 0; bj < 2; ++bj) xv[m][bj] = *(const GAS u32x4*)(xb + (size_t)(rb + 16 * m) * DM + col0 + bj * 128);
#pragma unroll
            for (int m = 0; m < 4; ++m) {
                const int row = rb + 16 * m; float ss = 0.f;
#pragma unroll
                for (int bj = 0; bj < 2; ++bj) {
                    f32x4 xl, xh; unpack8(xv[m][bj], xl, xh);
                    const f32x4 x0 = xl + acc[ai][bj][m][0] * scale, x1 = xh + acc[ai][bj][m][1] * scale;
                    ss += (x0.x * x0.x + x0.y * x0.y) + (x0.z * x0.z + x0.w * x0.w) + (x1.x * x1.x + x1.y * x1.y) + (x1.z * x1.z + x1.w * x1.w);
                    u32x4 w; w.x = pk2(x0.x, x0.y); w.y = pk2(x0.z, x0.w); w.z = pk2(x1.x, x1.y); w.w = pk2(x1.z, x1.w);
                    *(GAS u32x4*)(xb + (size_t)row * DM + col0 + bj * 128) = w;
                }
                ss += __shfl_xor(ss, 16); ss += __shfl_xor(ss, 32);
                if (fq == 0) red[(row - u.pm * 256) * 4 + wc] = ss;
            }
        }
        asm volatile("s_waitcnt lgkmcnt(0)" ::: "memory"); __builtin_amdgcn_s_barrier(); asm volatile("" ::: "memory");
        { const int t = threadIdx.x; if (t < 256) { const f32x4 v = *(const LAS f32x4*)(red + 4 * t); ssq[(size_t)(u.pm * 256 + t) * 4 + u.pn] = (v.x + v.y) + (v.z + v.w); } }
        asm volatile("s_waitcnt lgkmcnt(0)" ::: "memory"); __builtin_amdgcn_s_barrier(); asm volatile("" ::: "memory");
    }
};
struct EpiIN {
    static constexpr bool PERM = true, AFTER_DRAIN = false;
    bf16* qkn; bf16* qkr; bf16* vt; bf16* gates; float* lf; float* widx; const float* ssq; const float* cosT; const float* sinT; const float* bfg; unsigned* kinf;
    __device__ __forceinline__ void operator()(AccRef acc, const pg8::Unit& u, int wr, int wc, int fr, int fq) const {
        const int row0 = u.pm * 256 + wr * 64 + fr, pn = u.pn;
        if (pn < 6) {
            const int d0 = 32 * (wc & 1) + 8 * fq;
            float kmx[2] = {0.f, 0.f};
#pragma unroll
            for (int ai = 0; ai < 2; ++ai) {
                EPI_GROUP(rb, row0 + ai * 128); float r4[4]; rstd16x4(ssq, rb, r4);
#pragma unroll
                for (int m = 0; m < 4; ++m) {
                    const int row = rb + 16 * m; const float r = r4[m];
#pragma unroll
                    for (int bj = 0; bj < 2; ++bj) {
                        const int slot = 4 * pn + 2 * bj + (wc >> 1);
                        if (slot < 22) {
                            const float sc = r * (slot < 6 ? C2_64 : ((slot >= 12 && slot < 17) ? 0.125f : 1.0f));
                            float h[8];
#pragma unroll
                            for (int n = 0; n < 2; ++n)
#pragma unroll
                                for (int j = 0; j < 4; ++j) h[4 * n + j] = acc[ai][bj][m][n][j] * sc;
                            *(GAS u32x4*)(qkn + ((size_t)slot * MTOK + row) * 64 + d0) = pack8(h);
                            if (slot >= 6 && slot < 12) {
#pragma unroll
                                for (int e = 0; e < 8; ++e) kmx[bj] = fmaxf(kmx[bj], fabsf(h[e]));
                            }
                        }
                    }
                }
            }
#pragma unroll
            for (int bj = 0; bj < 2; ++bj) {
                const int slot = 4 * pn + 2 * bj + (wc >> 1);
                if (slot >= 6 && slot < 12) {
                    float v = kmx[bj];
#pragma unroll
                    for (int o = 1; o < 64; o <<= 1) v = fmaxf(v, __shfl_xor(v, o));
                    if ((threadIdx.x & 63) == 0) atomicMax(kinf + (u.pm >> 4) * 8 + (slot - 6), __float_as_uint(v * 1.01f));
                }
            }
        } else if (pn < 11) {
            const int hs = 4 * (pn - 6) + wc, i0 = 8 * fq;
            if (hs < 19) {
                const float scl = hs < 5 ? C2_64 : 1.0f;
#pragma unroll
                for (int ai = 0; ai < 2; ++ai) {
                    EPI_GROUP(rb, row0 + ai * 128); float r4[4]; rstd16x4(ssq, rb, r4);
#pragma unroll
                    for (int mp = 0; mp < 2; ++mp) {
                    EPI_GROUP(rb2, rb + 32 * mp);
                    f32x4 cv[2][2], sv[2][2];
#pragma unroll
                    for (int mm = 0; mm < 2; ++mm)
#pragma unroll
                        for (int n = 0; n < 2; ++n) { cv[mm][n] = *((const GAS f32x4*)(cosT + (size_t)(rb2 + 16 * mm) * 32 + i0) + n); sv[mm][n] = *((const GAS f32x4*)(sinT + (size_t)(rb2 + 16 * mm) * 32 + i0) + n); }
#pragma unroll
                    for (int mm = 0; mm < 2; ++mm) {
                        const int m = 2 * mp + mm;
                        const int row = rb2 + 16 * mm; const float r = r4[m] * scl;
                        float o1[8], o2[8];
#pragma unroll
                        for (int n = 0; n < 2; ++n) { const f32x4 c = cv[mm][n], s = sv[mm][n];
#pragma unroll
                            for (int j = 0; j < 4; ++j) { const float x1 = acc[ai][0][m][n][j] * r, x2 = acc[ai][1][m][n][j] * r; o1[4 * n + j] = x1 * c[j] - x2 * s[j]; o2[4 * n + j] = x2 * c[j] + x1 * s[j]; } }
                        if (hs == 18) {
                            bf16* dst = qkr + (size_t)18 * MTOK * 64 + (((size_t)(row >> 5) * 8 + fq) * 32 + (row & 31)) * 8;
                            *(GAS u32x4*)(dst) = pack8(o1); *(GAS u32x4*)(dst + 4 * 32 * 8) = pack8(o2);
                        } else {
                            bf16* dst = qkr + ((size_t)hs * MTOK + row) * 64 + i0;
                            *(GAS u32x4*)(dst) = pack8(o1); *(GAS u32x4*)(dst + 32) = pack8(o2);
                        }
                    }
                    }
                }
            } else {
                if (fq < 2) {
#pragma unroll
                    for (int ai = 0; ai < 2; ++ai) {
                        EPI_GROUP(rb, row0 + ai * 128); float r4[4]; rstd16x4(ssq, rb, r4);
#pragma unroll
                        for (int m = 0; m < 4; ++m) {
                            const int row = rb + 16 * m; const float r = r4[m];
#pragma unroll
                            for (int n = 0; n < 2; ++n)
#pragma unroll
                                for (int j = 0; j < 4; ++j) { const int i = 8 * fq + 4 * n + j; const float v = acc[ai][0][m][n][j] * r;
                                    if (i < 6) lf[(size_t)i * MTOK + row] = logsigmoidf_(v + bfg[i]);
                                    else if (i < 14) widx[(size_t)row * 8 + (i - 6)] = v * WIDX_SCALE; }
                        }
                    }
                }
            }
        } else if (pn < 15) {
            const int d0 = 32 * (wc & 1) + 8 * fq;
#pragma unroll
            for (int ai = 0; ai < 2; ++ai) {
                EPI_GROUP(rb, row0 + ai * 128); float r4[4]; rstd16x4(ssq, rb, r4);
#pragma unroll
                for (int m = 0; m < 4; ++m) {
                    const int row = rb + 16 * m; const float r = r4[m];
                    const int b = row >> 12, tp = tperm(row & 4095);
#pragma unroll
                    for (int bj = 0; bj < 2; ++bj) {
                        const int v = 4 * (pn - 11) + 2 * bj + (wc >> 1);
                        bf16* base = vt + ((size_t)(v * 4 + b) * 64 + d0) * SEQ + tp;
#pragma unroll
                        for (int n = 0; n < 2; ++n)
#pragma unroll
                            for (int j = 0; j < 4; ++j) base[(size_t)(4 * n + j) * SEQ] = (bf16)(pk2(acc[ai][bj][m][n][j] * r, 0.f) & 0xffffu);
                    }
                }
            }
        } else {
            const int colb = 256 * (pn - 15) + 32 * wc + 8 * fq;
#pragma unroll
            for (int ai = 0; ai < 2; ++ai) {
                EPI_GROUP(rb, row0 + ai * 128); float r4[4]; rstd16x4(ssq, rb, r4);
#pragma unroll
                for (int m = 0; m < 4; ++m) {
                    const int row = rb + 16 * m; const float r = r4[m];
#pragma unroll
                    for (int bj = 0; bj < 2; ++bj) {
                        float h[8];
#pragma unroll
                        for (int n = 0; n < 2; ++n)
#pragma unroll
                            for (int j = 0; j < 4; ++j) h[4 * n + j] = sigmoidf_(acc[ai][bj][m][n][j] * r);
                        *(GAS u32x4*)(gates + (size_t)row * 3072 + colb + 128 * bj) = pack8(h);
                    }
                }
            }
        }
    }
};
struct BranchOrder {
    pg8::StaticOrder S;
    __device__ __forceinline__ bool next(int i, pg8::Unit& u) const { pg8::Unit b; if (!S.next(i / 3, b)) return false; const int br = i % 3; u.pm = br * (MTOK / 256) + b.pm; u.pn = br * (DM / 256) + b.pn; return true; }
    __device__ __forceinline__ void a_ready(const pg8::Unit&) const {}
    __device__ __forceinline__ void done(const pg8::Unit&) const {}
};
struct EpiBR {
    static constexpr bool PERM = true, AFTER_DRAIN = false;
    const bf16* gates; float* mf; bf16* mb;
    __device__ __forceinline__ void operator()(AccRef acc, const pg8::Unit& u, int wr, int wc, int fr, int fq) const {
        const int mode = u.pn >> 2, pn = u.pn & 3, pm = u.pm & 63;
        const int row0 = pm * 256 + wr * 64 + fr, col0 = pn * 256 + wc * 32 + fq * 8;
#pragma unroll
        for (int ai = 0; ai < 2; ++ai) {
            EPI_GROUP(rb, row0 + ai * 128);
            u32x4 gv[4][2], pv[4][2];
#pragma unroll
            for (int m = 0; m < 4; ++m)
#pragma unroll
                for (int bj = 0; bj < 2; ++bj) { gv[m][bj] = *(const GAS u32x4*)(gates + (size_t)(rb + 16 * m) * 3072 + mode * DM + col0 + 128 * bj);
                    pv[m][bj] = (u32x4){0u, 0u, 0u, 0u}; if (mode > 0) pv[m][bj] = *(const GAS u32x4*)(mb + (size_t)(rb + 16 * m) * DM + col0 + 128 * bj); }
#pragma unroll
            for (int m = 0; m < 4; ++m)
#pragma unroll
                for (int bj = 0; bj < 2; ++bj) {
                    f32x4 g0, g1, p0, p1; unpack8(gv[m][bj], g0, g1); unpack8(pv[m][bj], p0, p1);
                    const f32x4 v0 = acc[ai][bj][m][0] * g0 + p0, v1 = acc[ai][bj][m][1] * g1 + p1;
                    u32x4 w; w.x = pk2(v0.x, v0.y); w.y = pk2(v0.z, v0.w); w.z = pk2(v1.x, v1.y); w.w = pk2(v1.z, v1.w);
                    *(GAS u32x4*)(mb + (size_t)(rb + 16 * m) * DM + col0 + 128 * bj) = w;
                }
        }
    }
};
struct EpiCQ {
    static constexpr bool PERM = true, AFTER_DRAIN = false;
    bf16* caq; const float* ssq;
    __device__ __forceinline__ void operator()(AccRef acc, const pg8::Unit& u, int wr, int wc, int fr, int fq) const {
        const int row0 = u.pm * 256 + wr * 64 + fr, d0 = 32 * wc + 8 * fq;
#pragma unroll
        for (int ai = 0; ai < 2; ++ai) {
            EPI_GROUP(rb, row0 + ai * 128); float r4[4]; rstd16x4(ssq, rb, r4);
#pragma unroll
            for (int m = 0; m < 4; ++m) {
                const int row = rb + 16 * m; const float r = r4[m] * C2_128;
#pragma unroll
                for (int bj = 0; bj < 2; ++bj) {
                    float h[8];
#pragma unroll
                    for (int n = 0; n < 2; ++n)
#pragma unroll
                        for (int j = 0; j < 4; ++j) h[4 * n + j] = acc[ai][bj][m][n][j] * r;
                    *(GAS u32x4*)(caq + ((size_t)(2 * u.pn + bj) * MTOK + row) * 128 + d0) = pack8(h);
                }
            }
        }
    }
};
struct EpiCKV {
    static constexpr bool PERM = true, AFTER_DRAIN = false;
    bf16* mk; bf16* mvt; const float* memssq;
    __device__ __forceinline__ void operator()(AccRef acc, const pg8::Unit& u, int wr, int wc, int fr, int fq) const {
        const int b = u.pm, d0 = 32 * wc + 8 * fq, two = u.pn >> 1;
#pragma unroll
        for (int ai = 0; ai < 2; ++ai)
#pragma unroll
            for (int m = 0; m < 4; ++m) {
                int mrow = ai * 128 + wr * 64 + m * 16 + fr; asm volatile("" : "+v"(mrow)); const float r = __builtin_amdgcn_rsqf(memssq[b * 256 + mrow] * (1.0f / DM) + EPS);
#pragma unroll
                for (int bj = 0; bj < 2; ++bj) {
                    const int h = 2 * (u.pn & 1) + bj;
                    if (!two) {
                        float hh[8];
#pragma unroll
                        for (int n = 0; n < 2; ++n)
#pragma unroll
                            for (int j = 0; j < 4; ++j) hh[4 * n + j] = acc[ai][bj][m][n][j] * r;
                        *(GAS u32x4*)(mk + ((size_t)(b * 4 + h) * 256 + mrow) * 128 + d0) = pack8(hh);
                    } else {
                        bf16* base = mvt + ((size_t)(b * 4 + h) * 128 + d0) * 256 + tperm(mrow);
#pragma unroll
                        for (int n = 0; n < 2; ++n)
#pragma unroll
                            for (int j = 0; j < 4; ++j) base[(size_t)(4 * n + j) * 256] = (bf16)(pk2(acc[ai][bj][m][n][j] * r, 0.f) & 0xffffu);
                    }
                }
            }
    }
};


__device__ __forceinline__ int srccol_gu(int n) { const int t = n >> 8, w = n & 255; return w < 128 ? 128 * t + w : DFF + 128 * t + (w - 128); }
__device__ __forceinline__ int srccol_in(int n) {
    const int pn = n >> 8, w = n & 255;
    if (pn < 6) { const int slot = 4 * pn + (w >> 6), d = w & 63;
        if (slot < 6) return 64 * slot + d; if (slot < 12) return 384 + 64 * (slot - 6) + d; if (slot < 17) return 2702 + 64 * (slot - 12) + d; if (slot < 22) return 3022 + 64 * (slot - 17) + d; return -1; }
    if (pn < 11) { const int bj = w >> 7, hs = 4 * (pn - 6) + ((w & 127) >> 5), i = w & 31, d = 32 * bj + i;
        if (hs < 5) return 1158 + 64 * hs + d; if (hs < 10) return 1478 + 64 * (hs - 5) + d; if (hs < 18) return 2118 + 64 * (hs - 10) + d; if (hs == 18) return 2630 + d;
        if (bj == 0) { if (i < 6) return 1152 + i; if (i < 14) return 2694 + (i - 6); }
        return -1; }
    if (pn < 15) { const int v = 4 * (pn - 11) + (w >> 6), d = w & 63;
        if (v < 6) return 768 + 64 * v + d; if (v < 11) return 1798 + 64 * (v - 6) + d; return 3342 + 64 * (v - 11) + d; }
    return 3662 + 256 * (pn - 15) + w;
}
template <int MAP>
__device__ __forceinline__ void conv_item(const float* W, int Ksrc, int Nsrc, bf16* WT, int Kdst, const float* gain, LAS float* scr, int kb, int nb, int lane) {
    const int k0 = 64 * kb, n0 = 32 * nb, n = n0 + (lane & 31);
    const int sc = MAP == 0 ? n : (MAP == 1 ? srccol_gu(n) : srccol_in(n));
    float v[32];
    const bool live = (sc >= 0) && (k0 < Ksrc);
    const GAS float* src = (const GAS float*)W + (size_t)(k0 + (lane >> 5)) * Nsrc + (live ? sc : 0);
#pragma unroll
    for (int i = 0; i < 32; ++i) v[i] = live ? src[(size_t)(2 * i) * Nsrc] : 0.f;
#pragma unroll
    for (int i = 0; i < 32; ++i) scr[(2 * i + (lane >> 5)) * 33 + (lane & 31)] = v[i];
    asm volatile("s_waitcnt lgkmcnt(0)" ::: "memory");
    const int c = lane & 7;
    f32x4 g0 = {1.f, 1.f, 1.f, 1.f}, g1 = g0;
    if (gain) { g0 = *(const GAS f32x4*)(gain + k0 + 8 * c); g1 = *(const GAS f32x4*)(gain + k0 + 8 * c + 4); }
#pragma unroll
    for (int j = 0; j < 4; ++j) { const int nn = (lane >> 3) + 8 * j; const LAS float* s = scr + (8 * c) * 33 + nn;
        u32x4 o; o.x = pk2(s[0 * 33] * g0.x, s[1 * 33] * g0.y); o.y = pk2(s[2 * 33] * g0.z, s[3 * 33] * g0.w); o.z = pk2(s[4 * 33] * g1.x, s[5 * 33] * g1.y); o.w = pk2(s[6 * 33] * g1.z, s[7 * 33] * g1.w);
        *(GAS u32x4*)(WT + (size_t)(n0 + nn) * Kdst + k0 + 8 * c) = o; }
    asm volatile("s_waitcnt lgkmcnt(0)" ::: "memory");
}
struct ConvMat { const float* W; const float* gain; bf16* WT; int Ksrc, Nsrc, Kdst, Ndst, map; };
__device__ __forceinline__ void conv_matrix(const ConvMat& cm, LAS float* scr, int gw, int NGW, int lane) {
    const int nblk = cm.Ndst / 32, nit = (cm.Kdst / 64) * nblk;
    for (int it = gw; it < nit; it += NGW) {
        const int kb = it / nblk, nb = it % nblk;
        if (cm.map == 0) conv_item<0>(cm.W, cm.Ksrc, cm.Nsrc, cm.WT, cm.Kdst, cm.gain, scr, kb, nb, lane);
        else if (cm.map == 1) conv_item<1>(cm.W, cm.Ksrc, cm.Nsrc, cm.WT, cm.Kdst, cm.gain, scr, kb, nb, lane);
        else conv_item<2>(cm.W, cm.Ksrc, cm.Nsrc, cm.WT, cm.Kdst, cm.gain, scr, kb, nb, lane);
    }
}

#define MFMA32(a, b, c) __builtin_amdgcn_mfma_f32_32x32x16_bf16((a), (b), (c), 0, 0, 0)
__device__ __forceinline__ int crow(int r, int hi) { return (r & 3) + 8 * (r >> 2) + 4 * hi; }

template <int NDT>
__device__ __forceinline__ void store_ot(bf16* Oh, int opitch, int q, int hi, const f32x16* o, float inv) {
#pragma unroll
    for (int dt = 0; dt < NDT; ++dt)
#pragma unroll
        for (int rg = 0; rg < 4; ++rg) {
            u32x2 w; w.x = pk2(o[dt][4 * rg] * inv, o[dt][4 * rg + 1] * inv); w.y = pk2(o[dt][4 * rg + 2] * inv, o[dt][4 * rg + 3] * inv);
            *(GAS u32x2*)(Oh + (size_t)q * opitch + 32 * dt + 8 * rg + 4 * hi) = w;
        }
}

__device__ __forceinline__ float xhalf_max(float x) { const auto rr = __builtin_amdgcn_permlane32_swap(__float_as_uint(x), __float_as_uint(x), false, false); return fmaxf(__uint_as_float(rr[0]), __uint_as_float(rr[1])); }
__device__ __forceinline__ float xhalf_sumf(float x) { const auto rr = __builtin_amdgcn_permlane32_swap(__float_as_uint(x), __float_as_uint(x), false, false); return __uint_as_float(rr[0]) + __uint_as_float(rr[1]); }
__device__ __forceinline__ float xhalf_other(float x, int hi) { const auto rr = __builtin_amdgcn_permlane32_swap(__float_as_uint(x), __float_as_uint(x), false, false); return __uint_as_float(hi ? rr[0] : rr[1]); }

#ifndef DSA_ASM_BFE
#define DSA_ASM_BFE 1
#endif
#ifndef FOX_TERM_SLOT
#define FOX_TERM_SLOT 3
#endif
#ifndef RESCALE_THR
#define RESCALE_THR 5.0f
#endif
#ifndef DSA_MFMA_SUM
#define DSA_MFMA_SUM 1
#endif
template <int NDT> struct FlashState { float m, l; bool started; f32x16 o[NDT]; f32x16 ol; f32x16 negm; };

template <int D, int MODE>
__device__ __forceinline__ void flash_qk(f32x16& p0, f32x16& p1, const f32x16& negm, const LAS unsigned char* Tb, const int* koff, const bf16x8* qr, const int t, const int qw0, const int q, const int hi, const LAS float* ncl2) {
    constexpr int ND0 = D / 16;
    if (MODE == 0) {
#pragma unroll
        for (int rg = 0; rg < 4; ++rg) { const f32x4 c0 = *(const LAS f32x4*)(ncl2 + 64 * t + 8 * rg + 4 * hi), c1 = *(const LAS f32x4*)(ncl2 + 64 * t + 32 + 8 * rg + 4 * hi);
#pragma unroll
            for (int j = 0; j < 4; ++j) { p0[4 * rg + j] = c0[j]; p1[4 * rg + j] = c1[j]; } }
    } else {
#pragma unroll
        for (int r = 0; r < 16; ++r) { p0[r] = 0.f; p1[r] = 0.f; }
    }
#pragma unroll
    for (int d0 = 0; d0 < ND0; ++d0) {
        const bf16x8 kf0 = *(const LAS bf16x8*)(Tb + koff[d0]), kf1 = *(const LAS bf16x8*)(Tb + koff[d0] + 512);
        p0 = MFMA32(kf0, qr[d0], p0); p1 = MFMA32(kf1, qr[d0], p1);
        if (D == 128) __builtin_amdgcn_sched_barrier(0);
    }
    if (MODE == 0) {
        if (64 * t + 63 > qw0) {
#pragma unroll
            for (int r = 0; r < 16; ++r) { const int kv = 64 * t + crow(r, hi); if (kv > q) p0[r] = -INFINITY; if (kv + 32 > q) p1[r] = -INFINITY; }
        }
    }
}
template <int D, int MODE>
__device__ __forceinline__ void flash_sv(FlashState<D / 32>& S, f32x16& p0, f32x16& p1, const float mref, const LAS unsigned char* Tb, const int* voff, const int hi, const unsigned long long mw) {
    constexpr int NDT = D / 32;
    float mx = fmaxf(fmaxf(p0[0], p1[0]), fmaxf(p0[1], p1[1]));
#pragma unroll
    for (int r = 2; r < 16; r += 2) mx = fmaxf(fmaxf(mx, p0[r]), fmaxf(p1[r], fmaxf(p0[r + 1], p1[r + 1])));
    mx = xhalf_max(mx);
    const float rel = mx - S.m; (void)mref;
    const float dl = S.started ? (rel > RESCALE_THR ? rel : 0.f) : rel;
    bool skip = false;
    if (MODE == 0) skip = S.started && __all(rel < -150.0f);
    S.started = true;
    if (skip) return;
    if (__any(dl != 0.f)) {
        const float alpha = fexp2(-dl); S.m += dl;
#pragma unroll
        for (int dt = 0; dt < NDT; ++dt)
#pragma unroll
            for (int r = 0; r < 16; ++r) S.o[dt][r] *= alpha;
        if (MODE == 1) S.l *= alpha;
        else {
#pragma unroll
            for (int r = 0; r < 16; ++r) S.ol[r] *= alpha;
        }
    }
    { const float m = S.m;
#pragma unroll
        for (int r = 0; r < 16; ++r) { p0[r] = fexp2(p0[r] - m); p1[r] = fexp2(p1[r] - m); }
    }
    if (MODE == 1) {
        const unsigned wlo = ((unsigned)mw) >> (4 * hi), whi = ((unsigned)(mw >> 32)) >> (4 * hi);
#pragma unroll
        for (int r = 0; r < 16; ++r) { const int bit = 8 * (r >> 2) + (r & 3);
            p0[r] = __uint_as_float(__float_as_uint(p0[r]) & (unsigned)__builtin_amdgcn_sbfe((int)wlo, bit, 1));
            p1[r] = __uint_as_float(__float_as_uint(p1[r]) & (unsigned)__builtin_amdgcn_sbfe((int)whi, bit, 1)); }
    }
    if (MODE == 1) { float rs = 0.f;
#pragma unroll
        for (int r = 0; r < 16; ++r) rs += p0[r] + p1[r];
        S.l += rs; }
    u32x4 pw[4];
#pragma unroll
    for (int s = 0; s < 2; ++s) {
        pw[s] = (u32x4){pk2(p0[8 * s], p0[8 * s + 1]), pk2(p0[8 * s + 2], p0[8 * s + 3]), pk2(p0[8 * s + 4], p0[8 * s + 5]), pk2(p0[8 * s + 6], p0[8 * s + 7])};
        pw[2 + s] = (u32x4){pk2(p1[8 * s], p1[8 * s + 1]), pk2(p1[8 * s + 2], p1[8 * s + 3]), pk2(p1[8 * s + 4], p1[8 * s + 5]), pk2(p1[8 * s + 6], p1[8 * s + 7])};
    }
#pragma unroll
    for (int g = 0; g < 4; ++g)
#pragma unroll
        for (int dt = 0; dt < NDT; ++dt) {
            const bf16x8 vf = *(const LAS bf16x8*)(Tb + D * 128 + voff[g] + 512 * dt);
            S.o[dt] = MFMA32(vf, __builtin_bit_cast(bf16x8, pw[g]), S.o[dt]);
            if (D == 128) __builtin_amdgcn_sched_barrier(0);
        }
    if (MODE != 1) {
        const unsigned one2 = ((threadIdx.x & 31) == 0) ? 0x3f803f80u : 0u;
        const bf16x8 vones = __builtin_bit_cast(bf16x8, (u32x4){one2, one2, one2, one2});
#pragma unroll
        for (int g = 0; g < 4; ++g) S.ol = MFMA32(vones, __builtin_bit_cast(bf16x8, pw[g]), S.ol);
    }
}

template <int MODE>
__device__ __forceinline__ void flash_tile3(FlashState<2>& S, bf16x8 (&kf)[8], const LAS unsigned char* Tb, const LAS unsigned char* Tn, const bool next_act, const int* koff, const bf16x8* qr,
                                            const int t, const int qw0, const int q, const int hi, const unsigned long long mw, const LAS float* ncl2, const bool act) {
    bool do_pv = false; u32x4 pw[4]; bf16x8 vf[8];
    if (act) {
        f32x16 p0, p1;
        if (MODE == 0) {
#pragma unroll
            for (int rg = 0; rg < 4; ++rg) { const f32x4 c0 = *(const LAS f32x4*)(ncl2 + 64 * t + 8 * rg + 4 * hi), c1 = *(const LAS f32x4*)(ncl2 + 64 * t + 32 + 8 * rg + 4 * hi);
#pragma unroll
                for (int j = 0; j < 4; ++j) { p0[4 * rg + j] = c0[j]; p1[4 * rg + j] = c1[j]; } }
        } else {
#pragma unroll
            for (int r = 0; r < 16; ++r) { p0[r] = 0.f; p1[r] = 0.f; }
        }
#pragma unroll
        for (int d0 = 0; d0 < 4; ++d0) { p0 = MFMA32(kf[2 * d0], qr[d0], p0); p1 = MFMA32(kf[2 * d0 + 1], qr[d0], p1); }
        if (MODE == 0) {
            if (64 * t + 63 > qw0) {
#pragma unroll
                for (int r = 0; r < 16; ++r) { const int kv = 64 * t + crow(r, hi); if (kv > q) p0[r] = -INFINITY; if (kv + 32 > q) p1[r] = -INFINITY; }
            }
        }
        float mx = fmaxf(fmaxf(p0[0], p1[0]), fmaxf(p0[1], p1[1]));
#pragma unroll
        for (int r = 2; r < 16; r += 2) mx = fmaxf(fmaxf(mx, p0[r]), fmaxf(p1[r], fmaxf(p0[r + 1], p1[r + 1])));
        mx = xhalf_max(mx);
        const float rel = mx - S.m;
        const float dl = S.started ? (rel > RESCALE_THR ? rel : 0.f) : rel;
        bool skip = false;
        if (MODE == 0) skip = S.started && __all(rel < -150.0f);
        S.started = true;
        if (!skip) {
            do_pv = true;
#pragma unroll
            for (int g = 0; g < 4; ++g) { vf[2 * g] = *(const LAS bf16x8*)(Tb + 8192 + koff[g]); vf[2 * g + 1] = *(const LAS bf16x8*)(Tb + 8192 + koff[g] + 512); }
            __builtin_amdgcn_sched_barrier(0);
            if (__any(dl != 0.f)) {
                const float alpha = fexp2(-dl); S.m += dl;
#pragma unroll
                for (int dt = 0; dt < 2; ++dt)
#pragma unroll
                    for (int r = 0; r < 16; ++r) S.o[dt][r] *= alpha;
                if (MODE == 1 && !DSA_MFMA_SUM) S.l *= alpha;
                else {
#pragma unroll
                    for (int r = 0; r < 16; ++r) S.ol[r] *= alpha;
                }
            }
            { const float m = S.m;
#pragma unroll
                for (int r = 0; r < 16; ++r) { p0[r] = fexp2(p0[r] - m); p1[r] = fexp2(p1[r] - m); } }
            if (MODE == 1) {
                const unsigned wlo = ((unsigned)mw) >> (4 * hi), whi = ((unsigned)(mw >> 32)) >> (4 * hi);
#pragma unroll
                for (int r = 0; r < 16; ++r) { const int bit = 8 * (r >> 2) + (r & 3);
#if DSA_ASM_BFE
                    unsigned t0, t1;
                    asm("v_bfe_i32 %0, %1, %2, 1" : "=v"(t0) : "v"(wlo), "n"(bit));
                    asm("v_bfe_i32 %0, %1, %2, 1" : "=v"(t1) : "v"(whi), "n"(bit));
                    p0[r] = __uint_as_float(__float_as_uint(p0[r]) & t0);
                    p1[r] = __uint_as_float(__float_as_uint(p1[r]) & t1); }
#else
                    p0[r] = __uint_as_float(__float_as_uint(p0[r]) & (unsigned)__builtin_amdgcn_sbfe((int)wlo, bit, 1));
                    p1[r] = __uint_as_float(__float_as_uint(p1[r]) & (unsigned)__builtin_amdgcn_sbfe((int)whi, bit, 1)); }
#endif
#if !DSA_MFMA_SUM
                float rs = 0.f;
#pragma unroll
                for (int r = 0; r < 16; ++r) rs += p0[r] + p1[r];
                S.l += rs;
#endif
            }
#pragma unroll
            for (int s = 0; s < 2; ++s) {
                pw[s] = (u32x4){pk2(p0[8 * s], p0[8 * s + 1]), pk2(p0[8 * s + 2], p0[8 * s + 3]), pk2(p0[8 * s + 4], p0[8 * s + 5]), pk2(p0[8 * s + 6], p0[8 * s + 7])};
                pw[2 + s] = (u32x4){pk2(p1[8 * s], p1[8 * s + 1]), pk2(p1[8 * s + 2], p1[8 * s + 3]), pk2(p1[8 * s + 4], p1[8 * s + 5]), pk2(p1[8 * s + 6], p1[8 * s + 7])};
            }
        }
    }
    if (next_act) {
#pragma unroll
        for (int d0 = 0; d0 < 4; ++d0) { kf[2 * d0] = *(const LAS bf16x8*)(Tn + koff[d0]); kf[2 * d0 + 1] = *(const LAS bf16x8*)(Tn + koff[d0] + 512); }
    }
    __builtin_amdgcn_sched_barrier(0);
    if (do_pv) {
#pragma unroll
        for (int g = 0; g < 4; ++g) { S.o[0] = MFMA32(vf[2 * g], __builtin_bit_cast(bf16x8, pw[g]), S.o[0]); S.o[1] = MFMA32(vf[2 * g + 1], __builtin_bit_cast(bf16x8, pw[g]), S.o[1]); }
        if (MODE != 1 || DSA_MFMA_SUM) {
            const unsigned one2 = ((threadIdx.x & 31) == 0) ? 0x3f803f80u : 0u;
            const bf16x8 vones = __builtin_bit_cast(bf16x8, (u32x4){one2, one2, one2, one2});
#pragma unroll
            for (int g = 0; g < 4; ++g) S.ol = MFMA32(vones, __builtin_bit_cast(bf16x8, pw[g]), S.ol);
        }
    }
}

template <int D, int MODE>
__device__ __forceinline__ void flash_unit(LAS unsigned char* lds, const bf16* Qh, const bf16* Kh, const bf16* VTh, const int vtp, bf16* Oh, const int opitch,
                                           const int q0, const int NT, const unsigned long long* mrow, const LAS float* ncl2, const float kinf = 0.f) {
    constexpr int KB = D * 128, NCH = D / 64, ND0 = D / 16, NDT = D / 32, CPR = D / 8;
    int tid_ = threadIdx.x; asm volatile("" : "+v"(tid_)); const int tid = tid_, lane = tid & 63, r32 = lane & 31, hi = lane >> 5, wid = __builtin_amdgcn_readfirstlane(tid >> 6);
    const int qw0 = q0 + 32 * wid, q = qw0 + r32;
    bf16x8 qr[ND0];
#pragma unroll
    for (int d0 = 0; d0 < ND0; ++d0) qr[d0] = *(const GAS bf16x8*)(Qh + (size_t)q * D + 16 * d0 + 8 * hi);
    unsigned ksrc[NCH], vsrc[NCH]; int kdst[NCH], vdst[NCH];
#pragma unroll
    for (int j = 0; j < NCH; ++j) { const int idx = tid + 512 * j; const int c = idx % CPR, kv = idx / CPR, cc = idx & 7, d = idx >> 3;
        ksrc[j] = (unsigned)(kv * D + 8 * c) * 2u; kdst[j] = c * 1024 + ((kv ^ (2 * c)) & 63) * 16; vsrc[j] = (unsigned)(d * vtp + 8 * cc) * 2u; vdst[j] = KB + cc * (D * 16) + (d ^ (2 * cc)) * 16; }
    int koff[ND0], voff_[D == 64 ? 1 : 4];
#pragma unroll
    for (int d0 = 0; d0 < ND0; ++d0) koff[d0] = (2 * d0 + hi) * 1024 + ((r32 ^ (4 * d0 + 2 * hi)) & 63) * 16;
    if (D != 64) {
#pragma unroll
        for (int g = 0; g < 4; ++g) voff_[D == 64 ? 0 : g] = (2 * g + hi) * (D * 16) + (r32 ^ (4 * g + 2 * hi)) * 16;
    }
    const int* voff = (D == 64) ? koff : voff_;
#define FL_TILE(i) ((MODE == 0) ? (NT - 1 - (i)) : (i))
#define FL_ACT(i) ((MODE != 0) || (64 * FL_TILE(i) <= qw0 + 31))
#define FL_LOAD(KR, VR, i) do { const int t_ = FL_TILE(i); const GAS char* kb_ = (const GAS char*)(Kh + (size_t)t_ * 64 * D); const GAS char* vb_ = (const GAS char*)(VTh + (size_t)t_ * 64); \
        _Pragma("unroll") for (int j_ = 0; j_ < NCH; ++j_) { KR[j_] = *(const GAS u32x4*)(kb_ + ksrc[j_]); VR[j_] = *(const GAS u32x4*)(vb_ + vsrc[j_]); } } while (0)
#define FL_STORE(KR, VR, b) do { _Pragma("unroll") for (int j_ = 0; j_ < NCH; ++j_) { *(LAS u32x4*)(lds + (b) * 2 * KB + kdst[j_]) = KR[j_]; *(LAS u32x4*)(lds + (b) * 2 * KB + vdst[j_]) = VR[j_]; } } while (0)
    FlashState<NDT> S; S.m = 0.f; S.l = 0.f; S.started = false;
#pragma unroll
    for (int r = 0; r < 16; ++r) { S.ol[r] = 0.f; S.negm[r] = 0.f; }
#pragma unroll
    for (int dt = 0; dt < NDT; ++dt)
#pragma unroll
        for (int r = 0; r < 16; ++r) S.o[dt][r] = 0.f;
    const unsigned mqo = (unsigned)q * 512u;
#define MQ(i) (*(const GAS unsigned long long*)((const GAS char*)mrow + (size_t)(i) * 8 + mqo))
    if constexpr (MODE == 2) {
        u32x4 kr[NCH], vr[NCH];
        for (int t = 0; t < NT; ++t) { FL_LOAD(kr, vr, t); FL_STORE(kr, vr, t); }
        __syncthreads();
        for (int t = 0; t < NT; ++t) { f32x16 p0, p1; const float mr = S.m; flash_qk<D, MODE>(p0, p1, S.negm, lds + t * 2 * KB, koff, qr, t, qw0, q, hi, ncl2); flash_sv<D, MODE>(S, p0, p1, mr, lds + t * 2 * KB, voff, hi, 0ull); }
        __syncthreads();
    } else {
        u32x4 kE[NCH], vE[NCH], kO[NCH], vO[NCH];
        unsigned long long wE = 0ull, wO = 0ull;
        bf16x8 kf[8];
        float qbound = 0.f; bool stop = false;
        LAS int* tflags = (LAS int*)(lds + 65536 + 16384 + 64);
        if (MODE == 0) { float s1 = 0.f;
#pragma unroll
            for (int d0 = 0; d0 < ND0; ++d0)
#pragma unroll
                for (int e = 0; e < 8; ++e) s1 += __uint_as_float(((unsigned)(unsigned short)qr[d0][e] & 0x7fffu) << 16);
            qbound = xhalf_sumf(s1) * kinf; }
        if (wid & 4) __builtin_amdgcn_s_setprio(1);
        FL_LOAD(kE, vE, 0); if (MODE == 1) wE = MQ(0);
        if (1 < NT) { FL_LOAD(kO, vO, 1); if (MODE == 1) wO = MQ(1); }
        FL_STORE(kE, vE, 0);
        if (1 < NT) FL_STORE(kO, vO, 1);
        if (2 < NT) FL_LOAD(kE, vE, 2);
        if (3 < NT) FL_LOAD(kO, vO, 3);
        __syncthreads();
        if (FL_ACT(0)) {
#pragma unroll
            for (int d0 = 0; d0 < 4; ++d0) { kf[2 * d0] = *(const LAS bf16x8*)(lds + koff[d0]); kf[2 * d0 + 1] = *(const LAS bf16x8*)(lds + koff[d0] + 512); }
        }
#define FL_STEP(i, SL, KP, VP, WL) do { \
            const unsigned long long mwc_ = WL; \
            if (MODE == 1) { if ((i) + 2 < NT) WL = MQ((i) + 2); } \
            { const bool nact_ = ((i) + 1 < NT) && FL_ACT((i) + 1); \
              flash_tile3<MODE>(S, kf, lds + (SL) * 2 * KB, lds + (((SL) + 1) & 3) * 2 * KB, nact_, koff, qr, FL_TILE(i), qw0, q, hi, mwc_, ncl2, FL_ACT(i)); } \
            if ((i) + 2 < NT) FL_STORE(KP, VP, ((SL) + 2) & 3);                                      \
            if ((i) + 4 < NT) FL_LOAD(KP, VP, (i) + 4);                                              \
            if (MODE == 0 && (SL) == FOX_TERM_SLOT) { const int t_ = FL_TILE(i); bool dead_ = false; \
                if (t_ > 0 && S.started) dead_ = __all(qbound + ncl2[64 * t_ - 1] - S.m < -150.0f); \
                if (lane == 0) tflags[(SL) * 8 + wid] = dead_ ? 1 : 0; } \
            __syncthreads(); \
            if (MODE == 0 && (SL) == FOX_TERM_SLOT) { const LAS int* fl_ = tflags + (SL) * 8; stop = (fl_[0] & fl_[1] & fl_[2] & fl_[3] & fl_[4] & fl_[5] & fl_[6] & fl_[7]) != 0; } \
            } while (0)
        for (int it = 0; it < NT; it += 4) {
            FL_STEP(it, 0, kE, vE, wE);
            if (stop || it + 1 >= NT) break;
            FL_STEP(it + 1, 1, kO, vO, wO);
            if (stop || it + 2 >= NT) break;
            FL_STEP(it + 2, 2, kE, vE, wE);
            if (stop || it + 3 >= NT) break;
            FL_STEP(it + 3, 3, kO, vO, wO);
            if (stop) break;
        }
        __builtin_amdgcn_s_setprio(0);
#undef FL_STEP
    }
    const float l = xhalf_sumf((MODE == 1 && !DSA_MFMA_SUM) ? S.l : (hi == 0 ? S.ol[0] : 0.f));
    store_ot<NDT>(Oh, opitch, q, hi, S.o, frcp(l));
#undef FL_LOAD
#undef FL_STORE
#undef FL_TILE
#undef FL_ACT
#undef MQ
}

__device__ __forceinline__ void sb_tile(float& carry, f32x16* o, const LAS unsigned char* Tb, const int* koff, const int* voff, const bf16x8* qr, const int j, const int q, const int hi, const int qw0) {
    f32x16 p0, p1;
#pragma unroll
    for (int r = 0; r < 16; ++r) { p0[r] = 0.f; p1[r] = 0.f; }
#pragma unroll
    for (int d0 = 0; d0 < 4; ++d0) {
        const bf16x8 kf0 = *(const LAS bf16x8*)(Tb + koff[d0]), kf1 = *(const LAS bf16x8*)(Tb + koff[d0] + 512);
        p0 = MFMA32(kf0, qr[d0], p0); p1 = MFMA32(kf1, qr[d0], p1);
    }
    float x[32], lb[32];
#pragma unroll
    for (int e = 0; e < 32; ++e) {
        const float z = e < 16 ? p0[e & 15] : p1[e & 15];
        const float lbv = logsigmoidf_(z);
        x[e] = lbv - z; lb[e] = lbv;
    }
    if (64 * j + 63 >= qw0) {
#pragma unroll
        for (int e = 0; e < 32; ++e) { const int kv = 64 * j + 32 * (e >> 4) + crow(e & 15, hi); if (!(kv < q)) { x[e] = 0.f; lb[e] = -INFINITY; } }
    }
    float gs[8], pr[8];
#pragma unroll
    for (int gl = 0; gl < 8; ++gl) gs[gl] = (x[4 * gl] + x[4 * gl + 1]) + (x[4 * gl + 2] + x[4 * gl + 3]);
#pragma unroll
    for (int gl = 0; gl < 8; ++gl) pr[gl] = xhalf_other(gs[gl], hi);
    float run = carry;
#pragma unroll
    for (int gl = 7; gl >= 0; --gl) {
        const float sg = run + (hi == 0 ? pr[gl] : 0.f);
        const float s3 = sg, s2 = s3 + x[4 * gl + 3], s1 = s2 + x[4 * gl + 2], s0 = s1 + x[4 * gl + 1];
        x[4 * gl + 3] = fexp2((lb[4 * gl + 3] + s3) * LOG2E); x[4 * gl + 2] = fexp2((lb[4 * gl + 2] + s2) * LOG2E);
        x[4 * gl + 1] = fexp2((lb[4 * gl + 1] + s1) * LOG2E); x[4 * gl] = fexp2((lb[4 * gl] + s0) * LOG2E);
        run += gs[gl] + pr[gl];
    }
    carry = run;
    u32x4 pw[4];
#pragma unroll
    for (int g = 0; g < 4; ++g) pw[g] = (u32x4){pk2(x[8 * g], x[8 * g + 1]), pk2(x[8 * g + 2], x[8 * g + 3]), pk2(x[8 * g + 4], x[8 * g + 5]), pk2(x[8 * g + 6], x[8 * g + 7])};
#pragma unroll
    for (int g = 0; g < 4; ++g)
#pragma unroll
        for (int dt = 0; dt < 2; ++dt) {
            const bf16x8 vf = *(const LAS bf16x8*)(Tb + 8192 + voff[g] + 512 * dt);
            o[dt] = MFMA32(vf, __builtin_bit_cast(bf16x8, pw[g]), o[dt]);
        }
}
__device__ __forceinline__ void sb_unit(LAS unsigned char* lds, const bf16* Qh, const bf16* Kh, const bf16* VTh, bf16* Oh, const int q0) {
    constexpr int D = 64, KB = 8192;
    int tid_ = threadIdx.x; asm volatile("" : "+v"(tid_)); const int tid = tid_, lane = tid & 63, r32 = lane & 31, hi = lane >> 5, wid = __builtin_amdgcn_readfirstlane(tid >> 6);
    const int qw0 = q0 + 32 * wid, q = qw0 + r32;
    bf16x8 qr[4];
#pragma unroll
    for (int d0 = 0; d0 < 4; ++d0) qr[d0] = *(const GAS bf16x8*)(Qh + (size_t)q * D + 16 * d0 + 8 * hi);
    const int c_ = tid & 7, kv_ = tid >> 3;
    const unsigned ksrc = (unsigned)(kv_ * D + 8 * c_) * 2u; const int kdst = c_ * 1024 + ((kv_ ^ (2 * c_)) & 63) * 16;
    const unsigned vsrc = (unsigned)(kv_ * SEQ + 8 * c_) * 2u; const int vdst = KB + c_ * (D * 16) + (kv_ ^ (2 * c_)) * 16;
    int koff[4];
#pragma unroll
    for (int d0 = 0; d0 < 4; ++d0) koff[d0] = (2 * d0 + hi) * 1024 + ((r32 ^ (4 * d0 + 2 * hi)) & 63) * 16;
    const int* voff = koff;
    LAS int* flags = (LAS int*)(lds + 4 * KB);
    u32x4 kreg, vreg;
#define SB_LOAD(t) do { kreg = *(const GAS u32x4*)((const GAS char*)(Kh + (size_t)(t) * 64 * D) + ksrc); vreg = *(const GAS u32x4*)((const GAS char*)(VTh + (size_t)(t) * 64) + vsrc); } while (0)
#define SB_STORE(b) do { *(LAS u32x4*)(lds + (b) * 2 * KB + kdst) = kreg; *(LAS u32x4*)(lds + (b) * 2 * KB + vdst) = vreg; } while (0)
    float carry = 0.f; bool wdone = false; f32x16 o[2];
#pragma unroll
    for (int dt = 0; dt < 2; ++dt)
#pragma unroll
        for (int r = 0; r < 16; ++r) o[dt][r] = 0.f;
    const int jtop = (q0 >> 6) + 3;
    SB_LOAD(jtop); SB_STORE(0); __syncthreads();
    int it = 0;
    for (int j = jtop; j >= 0; --j, ++it) {
        const int buf = it & 1;
        if (j > 0) SB_LOAD(j - 1);
        const bool started = (64 * j <= qw0);
        if (started && !wdone) sb_tile(carry, o, lds + buf * 2 * KB, koff, voff, qr, j, q, hi, qw0);
        wdone = started && __all(carry < -104.0f);
        const bool done = wdone;
        if (buf && lane == 0) flags[wid] = done ? 1 : 0;
        if (j > 0) SB_STORE(buf ^ 1);
        __syncthreads();
        if (buf) {
            const int alld = flags[0] & flags[1] & flags[2] & flags[3] & flags[4] & flags[5] & flags[6] & flags[7];
            if (alld) break;
        }
    }
    store_ot<2>(Oh, 384, q, hi, o, 1.0f);
    __syncthreads();
#undef SB_LOAD
#undef SB_STORE
}

__device__ __forceinline__ unsigned fkey(float x) { const unsigned b = __float_as_uint(x); return b ^ ((unsigned)((int)b >> 31) | 0x80000000u); }
__device__ __forceinline__ float xhalf_sum(float x) { const auto rr = __builtin_amdgcn_permlane32_swap(__float_as_uint(x), __float_as_uint(x), false, false); return __uint_as_float(rr[0]) + __uint_as_float(rr[1]); }
__device__ __forceinline__ unsigned wave_sum_u32(unsigned v) {
    unsigned x = v;
    x += (unsigned)__builtin_amdgcn_update_dpp(0, (int)x, 0x111, 0xf, 0xf, true);
    x += (unsigned)__builtin_amdgcn_update_dpp(0, (int)x, 0x112, 0xf, 0xf, true);
    x += (unsigned)__builtin_amdgcn_update_dpp(0, (int)x, 0x114, 0xf, 0xf, true);
    x += (unsigned)__builtin_amdgcn_update_dpp(0, (int)x, 0x118, 0xf, 0xf, true);
    return (unsigned)__builtin_amdgcn_readlane((int)x, 15) + (unsigned)__builtin_amdgcn_readlane((int)x, 31) + (unsigned)__builtin_amdgcn_readlane((int)x, 47) + (unsigned)__builtin_amdgcn_readlane((int)x, 63);
}
typedef short s16x2 __attribute__((ext_vector_type(2)));
#define IDX_SCORES(KB_) do { const int key = 32 * s + r32; \
        f32x16 y_; _Pragma("unroll") for (int r = 0; r < 16; ++r) y_[r] = 0.f; \
        _Pragma("unroll") for (int rt = 0; rt < 2; ++rt) { \
            f32x16 acc; _Pragma("unroll") for (int r = 0; r < 16; ++r) acc[r] = 0.f; \
            _Pragma("unroll") for (int d0 = 0; d0 < 4; ++d0) acc = MFMA32(qa[rt][d0], KB_[d0], acc); \
            _Pragma("unroll") for (int s2 = 0; s2 < 2; ++s2) { u32x4 xp; \
                _Pragma("unroll") for (int jj = 0; jj < 4; ++jj) { const s16x2 pz = {0, 0}; \
                    const unsigned pkd = pk2(acc[8 * s2 + 2 * jj], acc[8 * s2 + 2 * jj + 1]); \
                    xp[jj] = __builtin_bit_cast(unsigned, __builtin_elementwise_max(__builtin_bit_cast(s16x2, pkd), pz)); } \
                y_ = MFMA32(wf[rt][s2], __builtin_bit_cast(bf16x8, xp), y_); } \
        } \
        if (32 * s + 31 > t0) {         \
            _Pragma("unroll") for (int r = 0; r < 4; ++r) if (key > t0 + 4 * hi + r) y_[r] = __uint_as_float(0xffffffffu); } \
        _Pragma("unroll") for (int r = 0; r < 4; ++r) sc[(4 * hi + r) * 4096 + key] = y_[r]; \
        } while (0)
struct IdxPre { bf16x8 k0[4], k1[4], k2[4]; bf16x8 qa[2][4]; f32x4 w0, w1; };
#define IDX_KLOAD(KR, ss) do { if ((ss) < nsub) { _Pragma("unroll") for (int d0 = 0; d0 < 4; ++d0) KR[d0] = *(const GAS bf16x8*)(kbase + (size_t)(ss) * 2048 + 512 * d0); } } while (0)
__device__ __forceinline__ void idx_preload(IdxPre& P, const bf16* QI, const bf16* KI, const float* WI, const int b, const int t0) {
    int tid_ = threadIdx.x; asm volatile("" : "+v"(tid_)); const int tid = tid_, lane = tid & 63, r32 = lane & 31, hi = lane >> 5, wid = __builtin_amdgcn_readfirstlane(tid >> 6);
    const int nk = t0 + 8, nsub = ((nk + 63) >> 6) * 2;
    const size_t tok0 = (size_t)b * SEQ + t0;
    const bf16* kbase = KI + ((size_t)b * 128 * 8 + hi) * 256 + (size_t)r32 * 8;
#define IDX_KLOADZ(KR, ss) do { if ((ss) < nsub) { _Pragma("unroll") for (int d0 = 0; d0 < 4; ++d0) KR[d0] = *(const GAS bf16x8*)(kbase + (size_t)(ss) * 2048 + 512 * d0); } \
        else { _Pragma("unroll") for (int d0 = 0; d0 < 4; ++d0) KR[d0] = (bf16x8){0, 0, 0, 0, 0, 0, 0, 0}; } } while (0)
    IDX_KLOADZ(P.k0, wid); IDX_KLOADZ(P.k1, wid + 8); IDX_KLOADZ(P.k2, wid + 16);
#undef IDX_KLOADZ
    const int h = r32 >> 2, qq = r32 & 3, qp = r32 & 7;
#pragma unroll
    for (int rt = 0; rt < 2; ++rt)
#pragma unroll
        for (int d0 = 0; d0 < 4; ++d0) P.qa[rt][d0] = *(const GAS bf16x8*)(QI + ((size_t)h * MTOK + tok0 + 4 * rt + qq) * 64 + 16 * d0 + 8 * hi);
    P.w0 = *(const GAS f32x4*)(WI + (tok0 + qp) * 8); P.w1 = *(const GAS f32x4*)(WI + (tok0 + qp) * 8 + 4);
}
__device__ __forceinline__ void idx_unit(LAS unsigned char* lds, IdxPre& P, const bf16* QI, const bf16* KI, const float* WI, unsigned long long* MASK, const int b, const int t0,
                                         const bool has_next, const int nb, const int nt0, const int what = 3) {
    int tid_ = threadIdx.x; asm volatile("" : "+v"(tid_)); const int tid = tid_, lane = tid & 63, r32 = lane & 31, hi = lane >> 5, wid = __builtin_amdgcn_readfirstlane(tid >> 6);
    LAS float* sc = (LAS float*)lds;
    const int nk = t0 + 8, nsub = ((nk + 63) >> 6) * 2;
    if (what & 1) {
        const bf16* kbase = KI + ((size_t)b * 128 * 8 + hi) * 256 + (size_t)r32 * 8;
        bf16x8 k0[4], k1[4], k2[4], k3_[4];
#pragma unroll
        for (int d0 = 0; d0 < 4; ++d0) { k0[d0] = P.k0[d0]; k1[d0] = P.k1[d0]; k2[d0] = P.k2[d0]; }
        int s = wid;
        bf16x8 qa[2][4]; bf16x8 wf[2][2];
#pragma unroll
        for (int rt = 0; rt < 2; ++rt)
#pragma unroll
            for (int d0 = 0; d0 < 4; ++d0) qa[rt][d0] = P.qa[rt][d0];
        { const int qp = r32 & 7;
          const f32x4 w0 = P.w0, w1 = P.w1;
          const float wh[2][2] = {{hi ? w0.y : w0.x, hi ? w0.w : w0.z}, {hi ? w1.y : w1.x, hi ? w1.w : w1.z}};
#pragma unroll
          for (int rt = 0; rt < 2; ++rt)
#pragma unroll
              for (int s2 = 0; s2 < 2; ++s2) { u32x4 f = {0u, 0u, 0u, 0u};
                  if (r32 < 8 && (qp >> 2) == rt) { const int q0_ = qp & 3;
#pragma unroll
                      for (int j = 0; j < 8; ++j) if ((j & 3) == q0_) { const unsigned bits = pk2(wh[s2][j >> 2], 0.f) & 0xffffu; f[j >> 1] |= (j & 1) ? (bits << 16) : bits; } }
                  wf[rt][s2] = __builtin_bit_cast(bf16x8, f); }
        }
        while (s < nsub) {
            IDX_KLOAD(k3_, s + 24); IDX_SCORES(k0); s += 8; if (s >= nsub) break;
            IDX_KLOAD(k0, s + 24); IDX_SCORES(k1); s += 8; if (s >= nsub) break;
            IDX_KLOAD(k1, s + 24); IDX_SCORES(k2); s += 8; if (s >= nsub) break;
            IDX_KLOAD(k2, s + 24); IDX_SCORES(k3_); s += 8;
        }
    }
    __syncthreads();
    for (int rs_ = 0; rs_ < ((what & 4) ? 2 : 1); ++rs_)
    if (what & 2) {
        const int t = t0 + wid, n = t + 1;
        const LAS float* row = sc + wid * 4096 + lane;
        GAS unsigned long long* mout = (GAS unsigned long long*)MASK + ((size_t)b * SEQ + t) * 64;
        const int nwords = ((t | 255) >> 6) + 1;
        const int nreg = (n + 63) >> 6;
        unsigned long long myword = 0ull;
        if (n <= 256) {
            if (lane < nwords) { const int rem = n - 64 * lane; myword = rem >= 64 ? ~0ull : (rem > 0 ? ((1ull << rem) - 1ull) : 0ull); }
        } else {
            unsigned k[64];
#pragma unroll
            for (int g = 0; g < 4; ++g) {
                if (nreg > 16 * g) {
                    float v[16];
#pragma unroll
                    for (int j = 0; j < 16; ++j) v[j] = row[64 * (16 * g + j)];
#pragma unroll
                    for (int j = 0; j < 16; ++j) k[16 * g + j] = (16 * g + j < nreg) ? fkey(v[j]) : 0u;
                } else {
#pragma unroll
                    for (int j = 0; j < 16; ++j) k[16 * g + j] = 0u;
                }
            }
            unsigned T = 0u, cge = (unsigned)n;
#define CNT_BLOCK(g) do { unsigned long long mm_[16]; \
                _Pragma("unroll") for (int j = 0; j < 16; ++j) asm volatile("v_cmp_le_u32_e64 %0, %1, %2" : "=s"(mm_[j]) : "s"(cand), "v"(k[16 * (g) + j])); \
                asm volatile("s_nop 4"); __builtin_amdgcn_sched_barrier(0);        \
                _Pragma("unroll") for (int j = 0; j < 16; ++j) c += (unsigned)__builtin_popcountll(mm_[j]); \
                __builtin_amdgcn_sched_barrier(0); } while (0)
#define CNT_ALL() do { CNT_BLOCK(0); if (nreg > 16) { CNT_BLOCK(1); if (nreg > 32) { CNT_BLOCK(2); if (nreg > 48) CNT_BLOCK(3); } } } while (0)
            unsigned plo[16], phi[16];
#define IDX_TRANSPOSE(G, PL) do { unsigned w_[16]; \
                _Pragma("unroll") for (int i = 0; i < 16; ++i) w_[i] = (k[32 * (G) + i] >> 16) | (k[32 * (G) + 16 + i] & 0xffff0000u); \
                _Pragma("unroll") for (int st = 0; st < 4; ++st) { const int s_ = 8 >> st; const unsigned m_ = st == 0 ? 0x00ff00ffu : (st == 1 ? 0x0f0f0f0fu : (st == 2 ? 0x33333333u : 0x55555555u)); \
                    _Pragma("unroll") for (int i = 0; i < 16; ++i) if ((i & s_) == 0) { const unsigned t_ = ((w_[i] >> s_) ^ w_[i + s_]) & m_; w_[i + s_] ^= t_; w_[i] ^= (t_ << s_); } } \
                _Pragma("unroll") for (int b_ = 0; b_ < 16; ++b_) PL[b_] = w_[b_]; } while (0)
            IDX_TRANSPOSE(0, plo);
            if (nreg > 32) { IDX_TRANSPOSE(1, phi); } else {
#pragma unroll
                for (int b_ = 0; b_ < 16; ++b_) phi[b_] = 0u; }
#undef IDX_TRANSPOSE
            unsigned alo = 0xffffffffu, ahi = nreg > 32 ? 0xffffffffu : 0u, above = 0u, T16 = 0u;
#pragma unroll
            for (int bit = 15; bit >= 0; --bit) {
                const unsigned xlo = alo & plo[bit], xhi = ahi & phi[bit];
                const unsigned c1 = wave_sum_u32((unsigned)__builtin_popcount(xlo) + (unsigned)__builtin_popcount(xhi));
                if (above + c1 >= 256u) { T16 |= 1u << bit; alo = xlo; ahi = xhi; }
                else { above += c1; alo ^= xlo; ahi ^= xhi; }
            }
            const unsigned nC = wave_sum_u32((unsigned)__builtin_popcount(alo) + (unsigned)__builtin_popcount(ahi));
            const unsigned cnt_hi = above, need1 = 256u - cnt_hi;
            T = T16 << 16; cge = cnt_hi + nC;
            if (T16 == 0u) {
                T = 0u; cge = (unsigned)n;
#pragma unroll 1
                for (int bit = 31; bit >= 0; --bit) { const unsigned cand = T | (1u << bit); unsigned c = 0u; CNT_ALL(); if (c >= 256u) { T = cand; cge = c; } }
            } else if (nC > need1) {
                if (nC <= 64u) {
                    unsigned ck = 0u; int slot = 0;
#pragma unroll
                    for (int j = 0; j < 64; ++j) {
                        unsigned long long mk_ = __ballot((((j < 32 ? alo : ahi) >> (j & 31)) & 1u) != 0u);
                        while (mk_) { const int l_ = __builtin_ctzll(mk_); const unsigned v_ = (unsigned)__builtin_amdgcn_readlane((int)k[j], l_);
                            { unsigned keep_; asm volatile("s_mov_b32 %1, m0\n\ts_mov_b32 m0, %3\n\ts_nop 4\n\tv_writelane_b32 %0, %2, m0\n\ts_mov_b32 m0, %1" : "+v"(ck), "=&s"(keep_) : "s"(v_), "s"(slot)); }
                            ++slot; mk_ &= mk_ - 1ull; }
                    }
#pragma unroll 1
                    for (int bit = 15; bit >= 0; --bit) {
                        const unsigned cand = T | (1u << bit);
                        const unsigned c = cnt_hi + (unsigned)__popcll(__ballot(ck >= cand));
                        if (c >= 256u) { T = cand; cge = c; }
                    }
                } else {
#pragma unroll 1
                    for (int bit = 15; bit >= 0; --bit) {
                        const unsigned cand = T | (1u << bit);
                        unsigned c = 0u;
                        CNT_ALL();
                        if (c >= 256u) { T = cand; cge = c; }
                    }
                }
            }
            unsigned mlo = 0u, mhi = 0u;
            if (cge == 256u) {
                const unsigned cand = T;
#pragma unroll
                for (int g = 0; g < 4; ++g) if (16 * g < nreg) {
                    unsigned long long mm_[16];
#pragma unroll
                    for (int j = 0; j < 16; ++j) asm volatile("v_cmp_le_u32_e64 %0, %1, %2" : "=s"(mm_[j]) : "s"(cand), "v"(k[16 * g + j]));
                    __builtin_amdgcn_sched_barrier(0);
#pragma unroll
                    for (int j = 0; j < 16; ++j) { asm volatile("s_nop 1\n\tv_writelane_b32 %0, %1, %2" : "+v"(mlo) : "s"((unsigned)mm_[j]), "i"(16 * g + j)); asm volatile("v_writelane_b32 %0, %1, %2" : "+v"(mhi) : "s"((unsigned)(mm_[j] >> 32)), "i"(16 * g + j)); }
                    __builtin_amdgcn_sched_barrier(0);
                }
            } else {
                unsigned cgt = 0u;
#pragma unroll
                for (int j = 0; j < 64; ++j) cgt += (unsigned)__popcll(__ballot(k[j] > T));
                const unsigned need = 256u - cgt;
                unsigned tie_run = 0u; const unsigned long long lt = (1ull << lane) - 1ull;
#pragma unroll
                for (int j = 0; j < 64; ++j) {
                    const bool eq = (k[j] == T);
                    const unsigned long long beq = __ballot(eq);
                    const bool sel = (k[j] > T) || (eq && (tie_run + (unsigned)__popcll(beq & lt)) < need);
                    tie_run += (unsigned)__popcll(beq);
                    const unsigned long long w_ = __ballot(sel);
                    asm volatile("s_nop 4\n\tv_writelane_b32 %0, %1, %2" : "+v"(mlo) : "s"((unsigned)w_), "i"(j)); asm volatile("v_writelane_b32 %0, %1, %2" : "+v"(mhi) : "s"((unsigned)(w_ >> 32)), "i"(j));
                }
            }
            myword = ((unsigned long long)mhi << 32) | mlo;
#undef CNT_BLOCK
#undef CNT_ALL
        }
        if (lane < nwords) mout[lane] = myword;
    }
    if (has_next) idx_preload(P, QI, KI, WI, nb, nt0);
    __syncthreads();
}
#undef IDX_KLOAD


struct Args { const float* in[22]; float* out; unsigned char* ws; int ph_lo, ph_hi; };
constexpr int NPHASES = 1 + DEPTH * 12 + 1;

constexpr int CV_NIT[12] = {(DM / 64) * (NGU / 32), (DFF / 64) * (DM / 32), (DM / 64) * (NIN / 32), 6 * (DM / 32), 6 * (DM / 32), 6 * (DM / 32), (DM / 64) * (DM / 32), (DM / 64) * (512 / 32),
                            (DM / 64) * (DM / 32), (512 / 64) * (DM / 32), (DM / 64) * (NGU / 32), (DFF / 64) * (DM / 32)};
constexpr int cv_start(int i) { int s = 0; for (int j = 0; j < i; ++j) s += CV_NIT[j]; return s; }
constexpr int CV_TOTAL = cv_start(12);
__device__ __forceinline__ void conv_layer(const Args& a, int l, LAS float* scr, int gw, int NGW, int lane) {
    const size_t L = (size_t)l;
    for (int g = gw; g < CV_TOTAL; g += NGW) {
        ConvMat cm; size_t off; const float* W0; const float* G0 = nullptr; int it;
#define CVCASE(i, wi, GSET, OFF, KS, NS, KD, ND, MP) if (g < cv_start(i + 1)) { it = g - cv_start(i); W0 = a.in[wi]; asm volatile("" : "+s"(W0)); GSET; off = (OFF); cm.Ksrc = (KS); cm.Nsrc = (NS); cm.Kdst = (KD); cm.Ndst = (ND); cm.map = (MP); }
        CVCASE(0, 4, { G0 = a.in[3]; asm volatile("" : "+s"(G0)); }, W_GU1, DM, NGU, DM, NGU, 1)
        else CVCASE(1, 5, {}, W_DN1, DFF, DM, DFF, DM, 0)
        else CVCASE(2, 7, { G0 = a.in[6]; asm volatile("" : "+s"(G0)); }, W_IN, DM, DIN, DM, NIN, 2)
        else CVCASE(3, 9, {}, W_BR, 384, DM, 384, DM, 0)
        else CVCASE(4, 10, {}, W_BR + (size_t)DM * 384 * 2, 320, DM, 384, DM, 0)
        else CVCASE(5, 11, {}, W_BR + (size_t)2 * DM * 384 * 2, 320, DM, 384, DM, 0)
        else CVCASE(6, 12, {}, W_OUT, DM, DM, DM, DM, 0)
        else CVCASE(7, 15, { G0 = a.in[13]; asm volatile("" : "+s"(G0)); }, W_CQ, DM, 512, DM, 512, 0)
        else CVCASE(8, 16, { G0 = a.in[14]; asm volatile("" : "+s"(G0)); }, W_CKV, DM, DM, DM, DM, 0)
        else CVCASE(9, 17, {}, W_CO, 512, DM, 512, DM, 0)
        else CVCASE(10, 19, { G0 = a.in[18]; asm volatile("" : "+s"(G0)); }, W_GU2, DM, NGU, DM, NGU, 1)
        else CVCASE(11, 20, {}, W_DN2, DFF, DM, DFF, DM, 0)
        else break;
#undef CVCASE
        cm.W = W0 + L * ((size_t)cm.Ksrc * cm.Nsrc); cm.gain = G0 ? G0 + L * DM : (const float*)nullptr; cm.WT = (bf16*)(a.ws + ((l & 1) ? WS_W2 : WS_W) + off);
        const int nblk = cm.Ndst / 32, kb = it / nblk, nb = it % nblk;
        if (cm.map == 0) conv_item<0>(cm.W, cm.Ksrc, cm.Nsrc, cm.WT, cm.Kdst, cm.gain, scr, kb, nb, lane);
        else if (cm.map == 1) conv_item<1>(cm.W, cm.Ksrc, cm.Nsrc, cm.WT, cm.Kdst, cm.gain, scr, kb, nb, lane);
        else conv_item<2>(cm.W, cm.Ksrc, cm.Nsrc, cm.WT, cm.Kdst, cm.gain, scr, kb, nb, lane);
    }
}

constexpr int MIX_NLV = 48, MIX_NUNITS = 1024, MIX_NCONV = 512;
#ifndef MIX_ORDER
#define MIX_ORDER 1
#endif
#if MIX_ORDER == 0
__constant__ const unsigned char MIX_LV_TYPE[48] = {1,1,1,1,1,1,1,1,0,1,0,0,0,0,1,0,0,0,0,1,0,0,1,0,1,0,1,0,1,0,2,2,2,2,2,2,2,2,2,2,2,2,2,2,2,2,1,0};
__constant__ const unsigned char MIX_LV_QB[48] = {15,14,13,12,11,10,9,8,15,7,14,13,12,11,6,10,9,8,7,5,6,5,4,4,3,3,2,2,1,1,15,14,13,12,11,10,9,8,7,6,5,4,3,2,1,0,0,0};
__constant__ const unsigned short MIX_LV_START[49] = {0,20,40,60,80,100,120,140,160,184,204,228,252,276,300,320,344,368,392,416,436,460,484,504,528,548,572,592,616,636,660,680,700,720,740,760,780,800,820,840,860,880,900,920,940,960,980,1000,1024};
#else
__constant__ const unsigned char MIX_LV_TYPE[48] = {1,0,1,0,1,0,1,0,1,0,1,0,1,0,1,0,1,0,1,0,1,0,1,0,2,2,2,2,2,2,2,2,2,2,2,2,2,2,2,2,1,0,1,0,1,0,1,0};
__constant__ const unsigned char MIX_LV_QB[48] = {15,15,14,14,13,13,12,12,11,11,10,10,9,9,8,8,7,7,6,6,5,5,4,4,15,14,13,12,11,10,9,8,7,6,5,4,3,2,1,0,3,3,2,2,1,1,0,0};
__constant__ const unsigned short MIX_LV_START[49] = {0,20,44,64,88,108,132,152,176,196,220,240,264,284,308,328,352,372,396,416,440,460,484,504,528,548,568,588,608,628,648,668,688,708,728,748,768,788,808,828,848,868,892,912,936,956,980,1000,1024};
#endif

#define WSO unsigned char* ws = a.ws; asm volatile("" : "+s"(ws)); float* x = a.out
#define xb ((bf16*)(ws + WS_XB))
#define ssq ((float*)(ws + WS_SSQ))
#define cosT ((float*)(ws + WS_COS))
#define sinT ((float*)(ws + WS_SIN))
#define memb ((bf16*)(ws + WS_MEMB))
#define memssq ((float*)(ws + WS_MEMSSQ))
#define lfb ((float*)(ws + WS_LF))
#define widx ((float*)(ws + WS_WIDX))
#define mk ((bf16*)(ws + WS_MK))
#define mvt ((bf16*)(ws + WS_MVT))
#define wl (ws + ((l & 1) ? WS_W2 : WS_W))
#define act ((bf16*)(ws + WS_ACT))
#define qkn ((bf16*)(ws + WS_QKN))
#define qkr ((bf16*)(ws + WS_QKR))
#define vt ((bf16*)(ws + WS_VT))
#define gates ((bf16*)(ws + WS_GATES))
#define maskb ((unsigned long long*)(ws + WS_MASK))
#define oatt ((bf16*)(ws + WS_OATT))
#define mf ((float*)(ws + WS_MF))
#define mb ((bf16*)(ws + WS_MB))
#define caq ((bf16*)(ws + WS_CAQ))
#define cao ((bf16*)(ws + WS_CAO))
__global__ void __launch_bounds__(NTHREADS, 2) mk_fwd(Args a) {
    extern __shared__ __attribute__((aligned(16))) unsigned char lds_raw[];
    LAS unsigned char* lds = (LAS unsigned char*)lds_raw;
    constexpr int G = 256, NGW = G * NWAVES; const int bx = blockIdx.x;
    if (threadIdx.x < 32) ((volatile LAS unsigned*)(lds + MISC_OFF))[threadIdx.x] = 0u;
    __syncthreads();
    (void)xcd_barrier_post((unsigned*)(a.ws + WS_CTL) + CW_BAR, (volatile LAS unsigned*)(lds + MISC_OFF) + 8);
#define TIDS int tid = threadIdx.x; asm volatile("" : "+v"(tid)); const int lane = tid & 63, wave = __builtin_amdgcn_readfirstlane(tid >> 6), gw = bx * NWAVES + wave; (void)lane; (void)gw

#if MK_PER_PHASE
    const int lo = a.ph_lo, hi_ph = a.ph_hi;
    int pid = 0;
#define PH_ON (lo <= pid && pid < hi_ph)
#else
#define PH_ON true
#endif
#ifndef TEST_SITE
#define TEST_SITE (-1)
#endif
#define SITE(k) (TEST_SITE < 0 || TEST_SITE == (k))
#ifndef PROBE_DUP
#define PROBE_DUP (-1)
#endif
#ifndef PROBE_REPS
#define PROBE_REPS 2
#endif
#define NREP(k) ((PROBE_DUP == (k)) ? PROBE_REPS : 1)
#ifndef QUEUE_AHEAD
#define QUEUE_AHEAD 0
#endif
#ifndef GEMM_ALIGN
#define GEMM_ALIGN true
#endif
#ifndef GEMM_SP2
#define GEMM_SP2 true
#endif
#ifndef CONV_FIRST
#define CONV_FIRST 0
#endif
#ifndef PROBE_DNK
#define PROBE_DNK(r) DFF
#endif
#ifndef PROBE_GUK
#define PROBE_GUK(r) DM
#endif
#if MK_PER_PHASE
#define PH_END do { ++pid; } while (0)
#else
#define PH_END do { { XcdBarrier bar_; bar_.bar = (unsigned*)(a.ws + WS_CTL) + CW_BAR; bar_.x = xb_xcc_id(); bar_.st = (volatile LAS unsigned*)(lds + MISC_OFF) + 8; xcd_barrier(bar_); } } while (0)
#endif
#define GEMM(EpiT, E, Aptr, Bptr, Mv, Nv, Kv, cid) do { pg8::Gemm g_{(const pg8::bf16_t*)(Aptr), (const pg8::bf16_t*)(Bptr), (Mv), (Nv), (Kv)}; pg8::StaticOrder S_; S_.init((Mv), (Nv), G, (cid)); \
        pg8::gemm_phase<EpiT, pg8::StaticOrder, GEMM_ALIGN, GEMM_SP2>(lds, g_, S_, E); } while (0)

    if (PH_ON && SITE(0)) for (int rep_ = 0; rep_ < NREP(0); ++rep_) { WSO; TIDS;
        const float* xin = a.in[0];
        for (int mrow = gw; mrow < MTOK; mrow += NGW) {
            const GAS f32x4* xr = (const GAS f32x4*)(xin + (size_t)mrow * DM) + lane;
            GAS u32x2* xbo = (GAS u32x2*)(xb + (size_t)mrow * DM) + lane; float s = 0.f;
#pragma unroll
            for (int j = 0; j < 4; ++j) { const f32x4 v = xr[64 * j]; s += (v.x * v.x + v.y * v.y) + (v.z * v.z + v.w * v.w); xbo[64 * j] = (u32x2){pk2(v.x, v.y), pk2(v.z, v.w)}; }
            s = wave_sum(s);
            if (lane < 4) ssq[(size_t)mrow * 4 + lane] = (lane == 0) ? s : 0.f;
        }
        const float* memin = a.in[1];
        for (int mrow = gw; mrow < MROWS; mrow += NGW) {
            const GAS f32x4* xr = (const GAS f32x4*)(memin + (size_t)mrow * DM) + lane; GAS u32x2* xbo = (GAS u32x2*)(memb + (size_t)mrow * DM) + lane; float s = 0.f;
#pragma unroll
            for (int j = 0; j < 4; ++j) { const f32x4 v = xr[64 * j]; s += (v.x * v.x + v.y * v.y) + (v.z * v.z + v.w * v.w); xbo[64 * j] = (u32x2){pk2(v.x, v.y), pk2(v.z, v.w)}; }
            s = wave_sum(s);
            if (lane == 0) memssq[mrow] = s;
        }
        const int* pos = (const int*)a.in[2];
        for (int idx = bx * NTHREADS + tid; idx < MTOK * 32; idx += G * NTHREADS) {
            const int row = idx >> 5, i = idx & 31;
            double f = 1.0; for (int k = 0; k < i; ++k) f *= 0.74989420933245582730;
            const float ang = (float)pos[row] * (float)f;
            const double ad = (double)ang; const double kk = __builtin_rint(ad * 0.15915494309189533577); const float red = (float)(ad - kk * 6.283185307179586476925);
            cosT[idx] = __builtin_amdgcn_cosf(red * 0.15915494309189535f); sinT[idx] = __builtin_amdgcn_sinf(red * 0.15915494309189535f);
        }
        conv_layer(a, 0, (LAS float*)(lds + wave * 16384), gw, NGW, lane);
#if defined(PROBE_CONV0)
        for (int pc_ = 0; pc_ < PROBE_CONV0; ++pc_) conv_layer(a, 0, (LAS float*)(lds + wave * 16384), gw, NGW, lane);
#endif
    }
    PH_END;

#define CONV_SLOTS (432 * NWAVES)
#define CONV_FILL(first_wg, slot0) do { if (l + 1 < DEPTH && bx >= (first_wg)) { TIDS; conv_layer(a, l + 1, (LAS float*)(lds + wave * 16384), (slot0) + (bx - (first_wg)) * NWAVES + wave, CONV_SLOTS, lane); } if (PROBE_DUP >= 0) __syncthreads(); } while (0)
    for (int hs = 0; hs < 2 * DEPTH; ++hs) {
        const int l = hs >> 1, second = hs & 1;
        if (PH_ON && SITE(2)) for (int rep_ = 0; rep_ < NREP(2); ++rep_) { WSO;
#if defined(PROBE_EPITRIV)
            EpiGU E{act, ssq, rep_ == 0 ? 1 : 0};
#else
            EpiGU E{act, ssq};
#endif
#if CONV_FIRST
            CONV_FILL(128, second ? 304 * NWAVES : 0); if (l + 1 < DEPTH && bx >= 128) __syncthreads();
            GEMM(EpiGU, E, xb, wl + (second ? W_GU2 : W_GU1), MTOK, NGU, PROBE_GUK(rep_), bx); }
#else
            GEMM(EpiGU, E, xb, wl + (second ? W_GU2 : W_GU1), MTOK, NGU, PROBE_GUK(rep_), bx); CONV_FILL(128, second ? 304 * NWAVES : 0); }
#endif
        PH_END;
        if (PH_ON && SITE(3)) for (int rep_ = 0; rep_ < NREP(3); ++rep_) { WSO; EpiRES E{xb, ssq, rep_ ? 0.f : 0.5f, (LAS float*)(lds + LDS_HIST)}; GEMM(EpiRES, E, act, wl + (second ? W_DN2 : W_DN1), MTOK, DM, PROBE_DNK(rep_), bx); }
        PH_END;
        if (second) continue;

        if (PH_ON && SITE(4)) for (int rep_ = 0; rep_ < NREP(4); ++rep_) { WSO; EpiIN E{qkn, qkr, vt, gates, lfb, widx, ssq, cosT, sinT, a.in[8] + l * 6, (unsigned*)(a.ws + WS_CTL) + CW_KINF + l * 32}; GEMM(EpiIN, E, xb, wl + W_IN, MTOK, NIN, DM, bx); CONV_FILL(192, 128 * NWAVES); }
        PH_END;
        if (PH_ON && SITE(5)) for (int rep_ = 0; rep_ < NREP(5); ++rep_) { WSO; TIDS;
            constexpr int NIDX = MTOK / 8;
            const bf16* QI_ = qkr + (size_t)10 * MTOK * 64; const bf16* KI_ = qkr + (size_t)18 * MTOK * 64;
#define IDX_AT(r_, b_, t_) do { const int c_ = ((r_) & 1) ? (G - 1 - bx) : bx; const int pi_ = (r_) * G + c_; b_ = pi_ % 4; t_ = 8 * ((NIDX / 4 - 1) - pi_ / 4); } while (0)
            IdxPre P_;
            { int b0_, t0_; IDX_AT(0, b0_, t0_); idx_preload(P_, QI_, KI_, widx, b0_, t0_); }
            for (int r = 0; r < NIDX / G; ++r) {
                int b, t0, nb, nt0; IDX_AT(r, b, t0); IDX_AT(r + 1, nb, nt0);
#if defined(PROBE_IDX)
                idx_unit(lds, P_, QI_, KI_, widx, maskb, b, t0, r + 1 < NIDX / G, nb, nt0, rep_ == 0 ? 3 : PROBE_IDX);
#else
                idx_unit(lds, P_, QI_, KI_, widx, maskb, b, t0, r + 1 < NIDX / G, nb, nt0);
#endif
            }
#undef IDX_AT
        }
        PH_END;
        if (PH_ON && SITE(6)) for (int rep_ = 0; rep_ < NREP(6); ++rep_) { WSO; TIDS;
            volatile LAS int* qslot = (volatile LAS int*)(lds + MISC_OFF) + 16;
            unsigned* qhead = (unsigned*)(a.ws + WS_CTL) + CW_QUEUE + 64 * (4 * l + rep_);
            const int ntot = MIX_NUNITS;
            unsigned nxt_ = 0u;
            if (QUEUE_AHEAD && tid == 0) nxt_ = __hip_atomic_fetch_add(qhead, 1u, RLX_AGENT);
            for (;;) {
                if (!QUEUE_AHEAD && tid == 0) nxt_ = __hip_atomic_fetch_add(qhead, 1u, RLX_AGENT);
                if (tid == 0) qslot[0] = (int)nxt_;
                __syncthreads();
                const int p = qslot[0];
                __syncthreads();
                if (p >= ntot) break;
                if (QUEUE_AHEAD && tid == 0) nxt_ = __hip_atomic_fetch_add(qhead, 1u, RLX_AGENT);
                int lv = 0;
                while (p >= (int)MIX_LV_START[lv + 1]) ++lv;
                const int type = MIX_LV_TYPE[lv], qb = MIX_LV_QB[lv], j = p - (int)MIX_LV_START[lv];
#if defined(MIX_ONLY)
                if (type != MIX_ONLY) continue;
#endif
#if defined(PROBE_TYPE)
                if (rep_ == 1 && type != PROBE_TYPE) continue;
#endif
                if (type == 0) {
                    const int b = j / 6, h = j % 6;
                    LAS float* cl2 = (LAS float*)(lds + 65536);
                    {
                        int tid = threadIdx.x; asm volatile("" : "+v"(tid)); const int lane = tid & 63, wave = __builtin_amdgcn_readfirstlane(tid >> 6);
                        const GAS f32x4* src = (const GAS f32x4*)(lfb + (size_t)h * MTOK + (size_t)b * SEQ + 8 * tid);
                        const f32x4 v0 = src[0], v1 = src[1];
                        float e[8]; e[0] = v0.x; e[1] = e[0] + v0.y; e[2] = e[1] + v0.z; e[3] = e[2] + v0.w; e[4] = e[3] + v1.x; e[5] = e[4] + v1.y; e[6] = e[5] + v1.z; e[7] = e[6] + v1.w;
                        float inc = e[7];
#pragma unroll
                        for (int o = 1; o < 64; o <<= 1) { const float v = __shfl_up(inc, o); if (lane >= o) inc += v; }
                        LAS float* wsum = (LAS float*)(lds + 65536 + 16384);
                        if (lane == 63) wsum[wave] = inc;
                        __syncthreads();
                        float off = inc - e[7];
                        for (int w = 0; w < wave; ++w) off += wsum[w];
#pragma unroll
                        for (int jj = 0; jj < 8; ++jj) cl2[8 * tid + jj] = -(off + e[jj]) * LOG2E;
                        __syncthreads();
                    }
                    const size_t hb = (size_t)b * SEQ * 64;
                    flash_unit<64, 0>(lds, qkn + (size_t)h * MTOK * 64 + hb, qkn + (size_t)(6 + h) * MTOK * 64 + hb, vt + (size_t)(h * 4 + b) * 64 * SEQ, SEQ,
                                      oatt + (size_t)b * SEQ * 384 + h * 64, 384, qb * 256, 4 * (qb + 1), nullptr, cl2,
                                      __uint_as_float(__hip_atomic_load((unsigned*)(a.ws + WS_CTL) + CW_KINF + l * 32 + b * 8 + h, RLX_AGENT)));
                } else {
                    const int b = j / 5, h = j % 5;
                    const size_t hb = (size_t)b * SEQ * 64;
                    if (type == 1) {
                        flash_unit<64, 1>(lds, qkr + (size_t)h * MTOK * 64 + hb, qkr + (size_t)(5 + h) * MTOK * 64 + hb, vt + (size_t)((6 + h) * 4 + b) * 64 * SEQ, SEQ,
                                          oatt + (size_t)MTOK * 384 + (size_t)b * SEQ * 384 + h * 64, 384, qb * 256, 4 * (qb + 1), maskb + (size_t)b * SEQ * 64, nullptr);
                    } else {
                        sb_unit(lds, qkn + (size_t)(12 + h) * MTOK * 64 + hb, qkn + (size_t)(17 + h) * MTOK * 64 + hb, vt + (size_t)((11 + h) * 4 + b) * 64 * SEQ,
                                oatt + (size_t)2 * MTOK * 384 + (size_t)b * SEQ * 384 + h * 64, qb * 256);
                    }
                    if (h == 4) {
                        int t2 = threadIdx.x; asm volatile("" : "+v"(t2));
                        bf16* ob = oatt + (size_t)type * MTOK * 384 + ((size_t)b * SEQ + qb * 256 + (t2 >> 1)) * 384 + 320 + 32 * (t2 & 1);
#pragma unroll
                        for (int jj = 0; jj < 4; ++jj) *(GAS u32x4*)(ob + 8 * jj) = (u32x4){0u, 0u, 0u, 0u};
                    }
                }
            }
        }
        PH_END;
        if (PH_ON && SITE(7)) for (int rep_ = 0; rep_ < NREP(7); ++rep_) { WSO;
            EpiBR E{gates, mf, mb}; pg8::Gemm g_{(const pg8::bf16_t*)oatt, (const pg8::bf16_t*)(wl + W_BR), 3 * MTOK, 3 * DM, 384}; BranchOrder S_; S_.S.init(MTOK, DM, G, bx);
            pg8::gemm_phase<EpiBR, BranchOrder, GEMM_ALIGN, GEMM_SP2>(lds, g_, S_, E);
        }
        PH_END;
        if (PH_ON && SITE(8)) for (int rep_ = 0; rep_ < NREP(8); ++rep_) { WSO; EpiRES E{xb, ssq, rep_ ? 0.f : 1.0f, (LAS float*)(lds + LDS_HIST)}; GEMM(EpiRES, E, mb, wl + W_OUT, MTOK, DM, DM, bx); }
        PH_END;
        if (PH_ON && SITE(9)) for (int rep_ = 0; rep_ < NREP(9); ++rep_) { WSO;
            { EpiCQ E{caq, ssq}; GEMM(EpiCQ, E, xb, wl + W_CQ, MTOK, 512, DM, bx); }
            { EpiCKV E{mk, mvt, memssq}; GEMM(EpiCKV, E, memb, wl + W_CKV, MROWS, DM, DM, (bx + G - 128) % G); }
            CONV_FILL(144, 192 * NWAVES);
        }
        PH_END;
        if (PH_ON && SITE(10)) for (int rep_ = 0; rep_ < NREP(10); ++rep_) { WSO;
            for (int p = bx; p < 256; p += G) {
                const int b = p >> 6, h = (p >> 4) & 3, qb = p & 15;
                flash_unit<128, 2>(lds, caq + ((size_t)h * MTOK + (size_t)b * SEQ) * 128, mk + (size_t)(b * 4 + h) * 256 * 128, mvt + (size_t)(b * 4 + h) * 128 * 256, 256,
                                   cao + (size_t)b * SEQ * 512 + h * 128, 512, qb * 256, 4, nullptr, nullptr);
            }
        }
        PH_END;
#if defined(PROBE_BAR)
        for (int eb_ = 0; eb_ < PROBE_BAR; ++eb_) PH_END;
#endif
        if (PH_ON && SITE(11)) for (int rep_ = 0; rep_ < NREP(11); ++rep_) { WSO; EpiRES E{xb, ssq, rep_ ? 0.f : 1.0f, (LAS float*)(lds + LDS_HIST)}; GEMM(EpiRES, E, cao, wl + W_CO, MTOK, DM, 512, bx); }
        PH_END;
    }
    if (PH_ON && SITE(12)) for (int rep_ = 0; rep_ < NREP(12); ++rep_) { WSO; TIDS;
        const float* gfin = a.in[21];
        f32x4 gv[4];
#pragma unroll
        for (int j = 0; j < 4; ++j) gv[j] = ((const GAS f32x4*)gfin)[lane + 64 * j];
        for (int mrow = gw; mrow < MTOK; mrow += NGW) {
            const float r = rstd16(ssq, mrow);
            const GAS u32x2* xi = (const GAS u32x2*)(xb + (size_t)mrow * DM) + lane;
            GAS f32x4* xo = (GAS f32x4*)(x + (size_t)mrow * DM) + lane;
#pragma unroll
            for (int j = 0; j < 4; ++j) { const u32x2 w = xi[64 * j]; f32x4 v = {__uint_as_float(w.x << 16), __uint_as_float(w.x & 0xffff0000u), __uint_as_float(w.y << 16), __uint_as_float(w.y & 0xffff0000u)}; v = v * r * gv[j]; xo[64 * j] = v; }
        }
    }
#undef PH_ON
#undef PH_END
#undef GEMM
}

extern "C" void kernel_launch(void* const* d_in, const int* in_sizes, int n_in, void* d_out, int out_size, void* d_ws, size_t ws_size, hipStream_t stream) {
    static int grid = 0;
    if (grid == 0) {
        if (n_in != 22 || out_size != MTOK * DM || ws_size < WS_END) { fprintf(stderr, "kernel_launch: unexpected shapes (n_in %d, out %d, ws %zu < %zu); nothing launched\n", n_in, out_size, ws_size, (size_t)WS_END); grid = -1; return; }
        int dev = 0, cus = 0, per_cu = 0;
        if (hipGetDevice(&dev) != hipSuccess || hipDeviceGetAttribute(&cus, hipDeviceAttributeMultiprocessorCount, dev) != hipSuccess) { grid = -1; return; }
        if (hipFuncSetAttribute((const void*)mk_fwd, hipFuncAttributeMaxDynamicSharedMemorySize, LDS_BYTES) != hipSuccess) { fprintf(stderr, "kernel_launch: hipFuncSetAttribute failed\n"); grid = -1; return; }
        if (hipOccupancyMaxActiveBlocksPerMultiprocessor(&per_cu, (const void*)mk_fwd, NTHREADS, LDS_BYTES) != hipSuccess || per_cu < 1) { fprintf(stderr, "kernel_launch: occupancy query reports %d\n", per_cu); }
        (void)hipGetLastError();
        if (cus < 256) { fprintf(stderr, "kernel_launch: %d CUs < 256; nothing launched\n", cus); grid = -1; return; }
        grid = 256;
    }
    if (grid < 0) return;
    (void)in_sizes;
    if (hipMemsetAsync((char*)d_ws + WS_CTL, 0, CTL_ZERO_BYTES, stream) != hipSuccess) return;
    Args a{};
    for (int i = 0; i < 22; ++i) a.in[i] = (const float*)d_in[i];
    a.out = (float*)d_out; a.ws = (unsigned char*)d_ws;
#if MK_PER_PHASE
    for (int p = 0; p < NPHASES; ++p) { a.ph_lo = p; a.ph_hi = p + 1; hipLaunchKernelGGL(mk_fwd, dim3(grid), dim3(NTHREADS), LDS_BYTES, stream, a); }
#else
    a.ph_lo = 0; a.ph_hi = NPHASES;
    hipLaunchKernelGGL(mk_fwd, dim3(grid), dim3(NTHREADS), LDS_BYTES, stream, a);
#endif
}
```

```cpp
#define MIX_ORDER 2
#include <hip/hip_runtime.h>
#include <cstdio>
#include <cstdint>
namespace pg8 {
#define PG8_LAS __attribute__((address_space(3)))
typedef unsigned short bf16_t;
typedef short bf16x8 __attribute__((ext_vector_type(8)));
typedef float f32x4 __attribute__((ext_vector_type(4)));
typedef unsigned u32x4 __attribute__((ext_vector_type(4)));
constexpr int BM = 256, BK = 64, HALF = 128, HTB = HALF * BK * 2  , STAGE_BYTES = 8 * HTB, NXCD = 8, WGM = 8;

__host__ __device__ __forceinline__ int lds_byte(int r, int c) { const int st = (r >> 4) * 2 + (c >> 5), rr = r & 15, cc = c & 31, ob = rr * 64 + cc * 2; return st * 1024 + (ob ^ (((ob >> 9) & 1) << 5)); }
__host__ __device__ __forceinline__ void stage_rc(int b, int& R, int& C) { const int st = b / 1024, sb = b % 1024, swz = sb ^ (((sb >> 9) & 1) << 5); R = (st >> 1) * 16 + swz / 64; C = (st & 1) * 32 + (swz % 64) / 2; }
__host__ __device__ __forceinline__ int perm32(int rho) { const int n = rho >> 4, i = rho & 15; return 8 * (i >> 2) + 4 * n + (i & 3); }

struct Unit { int pm, pn; };
struct Gemm { const bf16_t* A; const bf16_t* Bt; int M, N, K; };

struct StaticOrder {
    int nM, nN, nwg, G, c;
    __host__ __device__ void init(int M, int N, int G_, int c_) { nM = M / BM; nN = N / BM; nwg = nM * nN; G = G_; c = c_; }
    __host__ __device__ bool next(int i, Unit& u) const {
        const long L = (long)i * G + c; if (L >= nwg) return false;
        int wgid = (int)L; { const int q = nwg / NXCD, r = nwg % NXCD, xcd = wgid % NXCD, off = wgid / NXCD; wgid = (xcd < r ? xcd * (q + 1) : r * (q + 1) + (xcd - r) * q) + off; }
        const int nig = WGM * nN, gid = wgid / nig, fm = gid * WGM, gsz = (nM - fm) < WGM ? (nM - fm) : WGM;
        u.pm = fm + ((wgid % nig) % gsz); u.pn = (wgid % nig) / gsz; return true;
    }
    __device__ __forceinline__ void a_ready(const Unit&) const {}
    __device__ __forceinline__ void done(const Unit&) const {}
};

__device__ __forceinline__ unsigned cvt_pk_bf16(float lo, float hi) { unsigned r; asm volatile("v_cvt_pk_bf16_f32 %0, %1, %2" : "=v"(r) : "v"(lo), "v"(hi)); return r; }
typedef float f32x2 __attribute__((ext_vector_type(2)));

template <class Epi, class Sched, bool ALIGN_EPI = false, bool SP2 = false>
__device__ __forceinline__ void gemm_phase(PG8_LAS unsigned char* lds, const Gemm g, const Sched& S, const Epi& E) {
    int tid_ = threadIdx.x; asm volatile("" : "+v"(tid_));
    const int tid = tid_, wid = __builtin_amdgcn_readfirstlane(tid >> 6), lane = tid & 63, wr = wid >> 2, wc = wid & 3, fr = lane & 15, fq = lane >> 4;
    const int K = g.K, nt = K / BK;
    unsigned voffA[2], voffB[2];
#pragma unroll
    for (int i = 0; i < 2; ++i) { int R, C; stage_rc(tid * 16 + i * 8192, R, C); const int Rb = Epi::PERM ? ((R & ~31) + perm32(R & 31)) : R;
        voffA[i] = (unsigned)(R * K + C) * 2u; voffB[i] = (unsigned)(Rb * K + C) * 2u; }
    const size_t kstep = (size_t)(BK * 2);
    const size_t hstep = (size_t)HALF * K * 2;
    const size_t tstep = 2 * hstep;
    const unsigned ldsw = (unsigned)wid * 1024u;
    const int aoff = lds_byte(wr * 64 + fr, fq * 8), boff = lds_byte(wc * 32 + fr, fq * 8);
#define PG8_SA(b, h) (((b) * 2 + (h)) * HTB)
#define PG8_SB(b, h) ((4 + (b) * 2 + (h)) * HTB)
#define PG8_STAGE(bufoff, gbase, voff) do { _Pragma("unroll") for (int _i = 0; _i < 2; ++_i) \
        __builtin_amdgcn_global_load_lds((const unsigned*)((const char*)(gbase) + (voff)[_i]), (PG8_LAS unsigned*)(lds + (bufoff) + ldsw + _i * 8192), 16, 0, 0); } while (0)
#define PG8_LDA(dst, b, h) do { _Pragma("unroll") for (int m = 0; m < 4; ++m) _Pragma("unroll") for (int k = 0; k < 2; ++k) dst[m][k] = *(const PG8_LAS bf16x8*)(lds + PG8_SA(b, h) + aoff + m * 2048 + k * 1024); } while (0)
#define PG8_LDB(dst, b, h) do { _Pragma("unroll") for (int n = 0; n < 2; ++n) _Pragma("unroll") for (int k = 0; k < 2; ++k) dst[n][k] = *(const PG8_LAS bf16x8*)(lds + PG8_SB(b, h) + boff + n * 2048 + k * 1024); } while (0)
#define PG8_MMA(ai, bj, At, Bt) do { __builtin_amdgcn_s_setprio(1); _Pragma("unroll") for (int m = 0; m < 4; ++m) _Pragma("unroll") for (int n = 0; n < 2; ++n) _Pragma("unroll") for (int k = 0; k < 2; ++k) \
        acc[ai][bj][m][n] = __builtin_amdgcn_mfma_f32_16x16x32_bf16(Bt[n][k], At[m][k], acc[ai][bj][m][n], 0, 0, 0); __builtin_amdgcn_s_setprio(0); } while (0)
#define PG8_WAIT_V(n) asm volatile("s_waitcnt vmcnt(" #n ")" ::: "memory")
#define PG8_WAIT_L(n) asm volatile("s_waitcnt lgkmcnt(" #n ")" ::: "memory")
#define PG8_BAR __builtin_amdgcn_s_barrier()
#define PG8_SCHED __builtin_amdgcn_sched_barrier(0)
    Unit cur, nxt; int ui = 0;
    if (!S.next(0, cur)) return;
    f32x4 acc[2][2][4][2];
#pragma unroll
    for (int a = 0; a < 2; ++a)
#pragma unroll
        for (int b = 0; b < 2; ++b)
#pragma unroll
            for (int m = 0; m < 4; ++m)
#pragma unroll
                for (int n = 0; n < 2; ++n) acc[a][b][m][n] = (f32x4){0.f, 0.f, 0.f, 0.f};
    bf16x8 At[4][2], B0[2][2], B1[2][2];
    const char* cA = (const char*)g.A + (size_t)cur.pm * tstep; const char* cB = (const char*)g.Bt + (size_t)cur.pn * tstep;
    S.a_ready(cur);
    if constexpr (SP2) {
        PG8_STAGE(PG8_SB(0, 0), cB, voffB); PG8_STAGE(PG8_SB(0, 1), cB + hstep, voffB); PG8_STAGE(PG8_SA(0, 0), cA, voffA); PG8_STAGE(PG8_SA(0, 1), cA + hstep, voffA);
        if (wr == 1) PG8_BAR;
        PG8_WAIT_V(2); PG8_BAR;
        PG8_STAGE(PG8_SB(1, 0), cB + kstep, voffB); PG8_STAGE(PG8_SA(1, 0), cA + kstep, voffA); PG8_STAGE(PG8_SB(1, 1), cB + hstep + kstep, voffB);
        PG8_WAIT_V(6); PG8_BAR;
    } else {
        PG8_STAGE(PG8_SB(0, 0), cB, voffB); PG8_STAGE(PG8_SA(0, 0), cA, voffA); PG8_STAGE(PG8_SB(0, 1), cB + hstep, voffB); PG8_STAGE(PG8_SA(0, 1), cA + hstep, voffA);
        if (wr == 1) PG8_BAR;
        PG8_WAIT_V(4); PG8_BAR;
        PG8_STAGE(PG8_SB(1, 0), cB + kstep, voffB); PG8_STAGE(PG8_SA(1, 0), cA + kstep, voffA); PG8_STAGE(PG8_SB(1, 1), cB + hstep + kstep, voffB);
        PG8_WAIT_V(6); PG8_BAR;
    }
    for (;;) {
        const bool has_next = S.next(ui + 1, nxt);
        const char* nA = has_next ? (const char*)g.A + (size_t)nxt.pm * tstep : cA; const char* nB = has_next ? (const char*)g.Bt + (size_t)nxt.pn * tstep : cB;
#pragma unroll 1
        for (int t = 0; t < nt; t += 2) {
            const bool last = (t == nt - 2);
            const char* a1 = cA + (size_t)(t + 1) * kstep;
            const char* a2 = last ? nA : cA + (size_t)(t + 2) * kstep; const char* b2 = last ? nB : cB + (size_t)(t + 2) * kstep;
            const char* a3 = a2 + kstep; const char* b3 = b2 + kstep;
            if (last && has_next) S.a_ready(nxt);
            if constexpr (SP2) {
            PG8_LDB(B0, 0, 0); PG8_LDB(B1, 0, 1); PG8_SCHED; PG8_LDA(At, 0, 0); PG8_STAGE(PG8_SA(1, 1), a1 + hstep, voffA);
            PG8_WAIT_V(8); PG8_WAIT_L(0); PG8_BAR; PG8_MMA(0, 0, At, B0); PG8_MMA(0, 1, At, B1); PG8_BAR; PG8_SCHED;
            PG8_LDA(At, 0, 1); PG8_STAGE(PG8_SB(0, 0), b2, voffB); PG8_STAGE(PG8_SB(0, 1), b2 + hstep, voffB); PG8_STAGE(PG8_SA(0, 0), a2, voffA);
            PG8_WAIT_V(8); PG8_WAIT_L(0); PG8_BAR; PG8_MMA(1, 0, At, B0); PG8_MMA(1, 1, At, B1); PG8_BAR; PG8_SCHED;
            PG8_LDB(B0, 1, 0); PG8_LDB(B1, 1, 1); PG8_SCHED; PG8_LDA(At, 1, 0); PG8_STAGE(PG8_SA(0, 1), a2 + hstep, voffA);
            PG8_WAIT_V(8); PG8_WAIT_L(0); PG8_BAR; PG8_MMA(0, 0, At, B0); PG8_MMA(0, 1, At, B1); PG8_BAR; PG8_SCHED;
            PG8_LDA(At, 1, 1); PG8_STAGE(PG8_SB(1, 0), b3, voffB); PG8_STAGE(PG8_SB(1, 1), b3 + hstep, voffB); PG8_STAGE(PG8_SA(1, 0), a3, voffA);
            PG8_WAIT_V(8); PG8_WAIT_L(0); PG8_BAR; PG8_MMA(1, 0, At, B0); PG8_MMA(1, 1, At, B1); PG8_BAR; PG8_SCHED;
            } else {
            PG8_LDB(B0, 0, 0); PG8_SCHED; PG8_LDA(At, 0, 0); PG8_STAGE(PG8_SA(1, 1), a1 + hstep, voffA);
            PG8_WAIT_L(8); PG8_BAR; PG8_WAIT_L(0); PG8_MMA(0, 0, At, B0); PG8_BAR; PG8_SCHED;
            PG8_LDB(B1, 0, 1); PG8_STAGE(PG8_SB(0, 0), b2, voffB);
            PG8_BAR; PG8_WAIT_L(0); PG8_MMA(0, 1, At, B1); PG8_BAR;
            PG8_LDA(At, 0, 1); PG8_STAGE(PG8_SA(0, 0), a2, voffA);
            PG8_BAR; PG8_WAIT_L(0); PG8_MMA(1, 0, At, B0); PG8_BAR; PG8_SCHED;
            PG8_STAGE(PG8_SB(0, 1), b2 + hstep, voffB);
            PG8_WAIT_V(6); PG8_BAR; PG8_MMA(1, 1, At, B1); PG8_BAR;
            PG8_LDB(B0, 1, 0); PG8_SCHED; PG8_LDA(At, 1, 0); PG8_STAGE(PG8_SA(0, 1), a2 + hstep, voffA);
            PG8_WAIT_L(8); PG8_BAR; PG8_WAIT_L(0); PG8_MMA(0, 0, At, B0); PG8_BAR; PG8_SCHED;
            PG8_LDB(B1, 1, 1); PG8_STAGE(PG8_SB(1, 0), b3, voffB);
            PG8_BAR; PG8_WAIT_L(0); PG8_MMA(0, 1, At, B1); PG8_BAR;
            PG8_LDA(At, 1, 1); PG8_STAGE(PG8_SA(1, 0), a3, voffA);
            PG8_BAR; PG8_WAIT_L(0); PG8_MMA(1, 0, At, B0); PG8_BAR; PG8_SCHED;
            PG8_STAGE(PG8_SB(1, 1), b3 + hstep, voffB);
            PG8_WAIT_V(6); PG8_BAR; PG8_MMA(1, 1, At, B1); PG8_BAR;
            }
        }
        if constexpr (ALIGN_EPI) { if (wr == 0) PG8_BAR; }
        if constexpr (!Epi::AFTER_DRAIN) { E(acc, cur, wr, wc, fr, fq); S.done(cur); }
        if (!has_next) break;
#pragma unroll
        for (int a = 0; a < 2; ++a)
#pragma unroll
            for (int b = 0; b < 2; ++b)
#pragma unroll
                for (int m = 0; m < 4; ++m)
#pragma unroll
                    for (int n = 0; n < 2; ++n) acc[a][b][m][n] = (f32x4){0.f, 0.f, 0.f, 0.f};
        cur = nxt; cA = nA; cB = nB; ++ui;
        if constexpr (ALIGN_EPI) { if (wr == 1) PG8_BAR; }
    }
    PG8_WAIT_V(0);
    if constexpr (!ALIGN_EPI) { if (wr == 0) PG8_BAR; }
    PG8_BAR;
    if constexpr (Epi::AFTER_DRAIN) { E.fused(acc, cur, wr, wc, fr, fq, lds, wid, lane); S.done(cur); }
#undef PG8_SA
#undef PG8_SB
#undef PG8_STAGE
#undef PG8_LDA
#undef PG8_LDB
#undef PG8_MMA
#undef PG8_WAIT_V
#undef PG8_WAIT_L
#undef PG8_BAR
#undef PG8_SCHED
}
}

#define GAS __attribute__((address_space(1)))
#define LAS __attribute__((address_space(3)))
typedef unsigned short bf16;
typedef short bf16x8 __attribute__((ext_vector_type(8)));
typedef float f32x4 __attribute__((ext_vector_type(4)));
typedef float f32x2 __attribute__((ext_vector_type(2)));
typedef float f32x16 __attribute__((ext_vector_type(16)));
typedef unsigned u32x4 __attribute__((ext_vector_type(4)));
typedef unsigned u32x2 __attribute__((ext_vector_type(2)));
typedef __bf16 bf16x2_t __attribute__((ext_vector_type(2)));

#ifndef MK_PER_PHASE
#define MK_PER_PHASE 0
#endif

constexpr int BATCH = 4, SEQ = 4096, DM = 1024, DEPTH = 4, MTOK = BATCH * SEQ;
constexpr int DFF = 2816, NGU = 2 * DFF, DIN = 6734, NIN = 6912;
constexpr int NMEM = 256, MROWS = BATCH * NMEM;
constexpr float EPS = 1e-6f;
constexpr float LOG2E = 1.4426950408889634f, LN2 = 0.6931471805599453f;
constexpr float C2_64 = 0.125f * LOG2E;
constexpr float C2_128 = 0.08838834764831845f * LOG2E;
constexpr float WIDX_SCALE = 0.35355339059327373f * 0.125f;
constexpr int NTHREADS = 512, NWAVES = 8;

constexpr size_t MiB = (size_t)1 << 20;
constexpr size_t WS_CTL = 0, CTL_ZERO_BYTES = 1 * MiB;
constexpr size_t WS_COS = 1 * MiB, WS_SIN = 3 * MiB;
constexpr size_t WS_SSQ = 5 * MiB;
constexpr size_t WS_MEMB = 6 * MiB;
constexpr size_t WS_MEMSSQ = 8 * MiB;
constexpr size_t WS_LF = 9 * MiB;
constexpr size_t WS_WIDX = 10 * MiB;
constexpr size_t WS_MK = 11 * MiB, WS_MVT = 12 * MiB;
constexpr size_t WS_XB = 16 * MiB;
constexpr size_t WS_W = 48 * MiB;
constexpr size_t W_GU1 = 0, W_DN1 = W_GU1 + (size_t)NGU * DM * 2, W_IN = W_DN1 + (size_t)DM * DFF * 2, W_BR = W_IN + (size_t)NIN * DM * 2,
                 W_OUT = W_BR + (size_t)3 * DM * 384 * 2, W_CQ = W_OUT + (size_t)DM * DM * 2, W_CKV = W_CQ + (size_t)512 * DM * 2,
                 W_CO = W_CKV + (size_t)DM * DM * 2, W_GU2 = W_CO + (size_t)DM * 512 * 2, W_DN2 = W_GU2 + (size_t)NGU * DM * 2, W_END = W_DN2 + (size_t)DM * DFF * 2;
static_assert(W_END <= 56 * MiB, "weights region");
constexpr size_t WS_W2 = 104 * MiB;
constexpr size_t WS_R = 160 * MiB;
constexpr size_t WS_ACT = WS_R;
constexpr size_t WS_QKN = WS_R;
constexpr size_t WS_QKR = WS_R + 48 * MiB;
constexpr size_t WS_VT = WS_R + 88 * MiB;
constexpr size_t WS_GATES = WS_R + 120 * MiB;
constexpr size_t WS_MASK = WS_R + 216 * MiB;
constexpr size_t WS_OATT = WS_R + 224 * MiB;
constexpr size_t WS_MF = WS_R;
constexpr size_t WS_MB = WS_R + 64 * MiB;
constexpr size_t WS_CAQ = WS_R;
constexpr size_t WS_CAO = WS_R + 16 * MiB;
constexpr size_t WS_END = WS_R + 260 * MiB;

constexpr int CW_BAR = 4096;
constexpr int CW_QUEUE = 16384;
constexpr int CW_KINF = 20480;
constexpr int LDS_HIST = 131072;
constexpr int MISC_OFF = 139264 + 64;
constexpr int LDS_BYTES = 147456;

#define RLX_AGENT __ATOMIC_RELAXED, __HIP_MEMORY_SCOPE_AGENT
__device__ __forceinline__ unsigned pk2(float lo, float hi) { f32x2 v = {lo, hi}; bf16x2_t b = __builtin_convertvector(v, bf16x2_t); return __builtin_bit_cast(unsigned, b); }
__device__ __forceinline__ float bf2f(unsigned short h) { return __uint_as_float(((unsigned)h) << 16); }
__device__ __forceinline__ float wave_sum(float v) {
#pragma unroll
    for (int o = 1; o < 64; o <<= 1) v += __shfl_xor(v, o);
    return v;
}
__device__ __forceinline__ float fexp2(float x) { return __builtin_amdgcn_exp2f(x); }
__device__ __forceinline__ float flog2(float x) { return __builtin_amdgcn_logf(x); }
__device__ __forceinline__ float frcp(float x) { return __builtin_amdgcn_rcpf(x); }
__device__ __forceinline__ int tperm(int t) { return (t & ~12) | ((t & 4) << 1) | ((t & 8) >> 1); }

#define XB_TMO      128
#define XB_XCNT(j)  (256  + 64 * (j))
#define XB_XSUB(j)  (1280 + 64 * (j))
#define XB_XGEN(j)  (2304 + 64 * (j))
#define XB_TOP      3328
#define XB_TOPGEN   3392
#define XCD_BAR_WORDS 3456
#define XB_SPIN_CAP (1u << 18)

__device__ __forceinline__ unsigned xb_ld(unsigned* p)              { return __hip_atomic_load(p, __ATOMIC_RELAXED, __HIP_MEMORY_SCOPE_AGENT); }
__device__ __forceinline__ unsigned xb_add(unsigned* p, unsigned v) { return __hip_atomic_fetch_add(p, v, __ATOMIC_RELAXED, __HIP_MEMORY_SCOPE_AGENT); }
__device__ __forceinline__ unsigned xb_xcc_id() { return (unsigned)__builtin_amdgcn_s_getreg((3 << 11) | 20) & 0xFu; }
#define XB_SPIN(cond, bar) do { unsigned _sp = 0; while (cond) { __builtin_amdgcn_s_sleep(1); \
    if ((++_sp & 255u) == 0u) { if (xb_ld(&(bar)[XB_TMO])) break; if (_sp > XB_SPIN_CAP) { atomicAdd(&(bar)[XB_TMO], 1u); break; } } } } while (0)

struct XcdBarrier {
    unsigned* bar; unsigned x;
    volatile LAS unsigned* st;
};

__device__ __forceinline__ XcdBarrier xcd_barrier_post(unsigned* bar, volatile LAS unsigned* st) {
    XcdBarrier b; b.bar = bar; b.x = xb_xcc_id(); b.st = st;
    if (threadIdx.x == 0) (void)xb_add(&bar[XB_XCNT(b.x)], 1u);
    return b;
}
__device__ __forceinline__ void xcd_barrier_complete(unsigned* bar, unsigned x, unsigned& nloc, unsigned& nx) {
    const unsigned G = gridDim.x * gridDim.y * gridDim.z;
    unsigned sum, cnt, mine, sp = 0u;
    for (;;) {
        sum = 0u; cnt = 0u; mine = 0u;
#pragma unroll
        for (unsigned j = 0; j < 16; ++j) { const unsigned c = xb_ld(&bar[XB_XCNT(j)]); sum += c; cnt += (c > 0u) ? 1u : 0u; mine = (j == x) ? c : mine; }
        if (sum == G) break;
        __builtin_amdgcn_s_sleep(1);
        if ((++sp & 255u) == 0u) { if (xb_ld(&bar[XB_TMO])) break; if (sp > XB_SPIN_CAP) { atomicAdd(&bar[XB_TMO], 1u); break; } }
    }
    nloc = mine > 0u ? mine : 1u; nx = cnt > 0u ? cnt : 1u;
}

__device__ __forceinline__ void xcd_barrier(const XcdBarrier& b) {
    asm volatile("s_waitcnt vmcnt(0)" ::: "memory");
    __syncthreads();
    if (threadIdx.x == 0) {
        unsigned* bar = b.bar;
        __builtin_amdgcn_s_waitcnt(0);
        unsigned nloc = b.st[0], nx = b.st[1];
        if (nloc == 0u) { xcd_barrier_complete(bar, b.x, nloc, nx); b.st[0] = nloc; b.st[1] = nx; }
        const unsigned old = xb_add(&bar[XB_XSUB(b.x)], 1u);
        const unsigned gen = old / nloc;
        if (old + 1u == (gen + 1u) * nloc) {
            __builtin_amdgcn_fence(__ATOMIC_RELEASE, "agent");
            asm volatile("s_waitcnt vmcnt(0)" ::: "memory");
            const unsigned og = xb_add(&bar[XB_TOP], 1u);
            const unsigned tg = og / nx;
            if (og + 1u == (tg + 1u) * nx) xb_add(&bar[XB_TOPGEN], 1u);
            else XB_SPIN(xb_ld(&bar[XB_TOPGEN]) == tg, bar);
            __builtin_amdgcn_fence(__ATOMIC_ACQUIRE, "agent");
            xb_add(&bar[XB_XGEN(b.x)], 1u);
            asm volatile("s_waitcnt vmcnt(0)" ::: "memory");
        } else {
            XB_SPIN(xb_ld(&bar[XB_XGEN(b.x)]) == gen, bar);
            __builtin_amdgcn_fence(__ATOMIC_ACQUIRE, "agent");
            asm volatile("s_waitcnt vmcnt(0)" ::: "memory");
        }
    }
    __syncthreads();
}
typedef const pg8::f32x4 (&AccRef)[2][2][4][2];
#define EPI_GROUP(rb, base) int rb = (base); asm volatile("" : "+v"(rb))

__device__ __forceinline__ void rstd16x4(const float* ssq, int rb, float (&r)[4]) {
    f32x4 p[4];
#pragma unroll
    for (int m = 0; m < 4; ++m) p[m] = *(const GAS f32x4*)(ssq + (size_t)(rb + 16 * m) * 4);
#pragma unroll
    for (int m = 0; m < 4; ++m) r[m] = __builtin_amdgcn_rsqf(((p[m].x + p[m].y) + (p[m].z + p[m].w)) * (1.0f / DM) + EPS);
}
__device__ __forceinline__ void rstd16x8(const float* ssq, int row0, float (&r)[2][4]) {
    f32x4 p[2][4];
#pragma unroll
    for (int ai = 0; ai < 2; ++ai)
#pragma unroll
        for (int m = 0; m < 4; ++m) p[ai][m] = *(const GAS f32x4*)(ssq + (size_t)(row0 + 128 * ai + 16 * m) * 4);
#pragma unroll
    for (int ai = 0; ai < 2; ++ai)
#pragma unroll
        for (int m = 0; m < 4; ++m) r[ai][m] = __builtin_amdgcn_rsqf(((p[ai][m].x + p[ai][m].y) + (p[ai][m].z + p[ai][m].w)) * (1.0f / DM) + EPS);
}
__device__ __forceinline__ float rstd16(const float* ssq, int row) {
    const f32x4 a = *(const GAS f32x4*)(ssq + (size_t)row * 4);
    return __builtin_amdgcn_rsqf(((a.x + a.y) + (a.z + a.w)) * (1.0f / DM) + EPS);
}
__device__ __forceinline__ u32x4 pack8(const float* h) { u32x4 w; w.x = pk2(h[0], h[1]); w.y = pk2(h[2], h[3]); w.z = pk2(h[4], h[5]); w.w = pk2(h[6], h[7]); return w; }
__device__ __forceinline__ float sigmoidf_(float x) { return frcp(1.f + fexp2(-x * LOG2E)); }
__device__ __forceinline__ float logsigmoidf_(float z) { return fminf(z, 0.f) - LN2 * flog2(1.f + fexp2(-fabsf(z) * LOG2E)); }
__device__ __forceinline__ void unpack8(const u32x4 w, f32x4& lo, f32x4& hi) {
    lo.x = __uint_as_float(w.x << 16); lo.y = __uint_as_float(w.x & 0xffff0000u); lo.z = __uint_as_float(w.y << 16); lo.w = __uint_as_float(w.y & 0xffff0000u);
    hi.x = __uint_as_float(w.z << 16); hi.y = __uint_as_float(w.z & 0xffff0000u); hi.z = __uint_as_float(w.w << 16); hi.w = __uint_as_float(w.w & 0xffff0000u);
}

struct EpiGU {
    static constexpr bool PERM = true, AFTER_DRAIN = false;
    bf16* act; const float* ssq;
#if defined(PROBE_EPITRIV)
    int triv;
#endif
    __device__ __forceinline__ void operator()(AccRef acc, const pg8::Unit& u, int wr, int wc, int fr, int fq) const {
        const int row0 = u.pm * 256 + wr * 64 + fr, col = u.pn * 128 + wc * 32 + fq * 8;
#if defined(PROBE_EPITRIV)
        if (triv) {
#if PROBE_EPITRIV == 2
            return;
#endif
#pragma unroll
            for (int ai = 0; ai < 2; ++ai)
#pragma unroll
                for (int m = 0; m < 4; ++m) { float h[8];
#pragma unroll
                    for (int n = 0; n < 2; ++n)
#pragma unroll
                        for (int j = 0; j < 4; ++j) h[4 * n + j] = acc[ai][0][m][n][j] * acc[ai][1][m][n][j];
                    *(GAS u32x4*)(act + (size_t)(row0 + ai * 128 + 16 * m) * DFF + col) = pack8(h); }
            return;
        }
#endif
        float r8[2][4]; rstd16x8(ssq, row0, r8);
#pragma unroll
        for (int ai = 0; ai < 2; ++ai) {
            EPI_GROUP(rb, row0 + ai * 128);
#pragma unroll
            for (int m = 0; m < 4; ++m) {
                const float r = r8[ai][m]; float h[8];
#pragma unroll
                for (int n = 0; n < 2; ++n)
#pragma unroll
                    for (int j = 0; j < 4; ++j) { const float g = acc[ai][0][m][n][j] * r, uu = acc[ai][1][m][n][j] * r; h[4 * n + j] = g * sigmoidf_(g) * uu; }
#if defined(GU_NT)
                __builtin_nontemporal_store(pack8(h), (GAS u32x4*)(act + (size_t)(rb + 16 * m) * DFF + col));
#else
                *(GAS u32x4*)(act + (size_t)(rb + 16 * m) * DFF + col) = pack8(h);
#endif
            }
        }
    }
};
struct EpiRES {
    static constexpr bool PERM = true, AFTER_DRAIN = false;
    bf16* xb; float* ssq; float scale; LAS float* red;
    __device__ __forceinline__ void operator()(AccRef acc, const pg8::Unit& u, int wr, int wc, int fr, int fq) const {
        const int row0 = u.pm * 256 + wr * 64 + fr, col0 = u.pn * 256 + wc * 32 + fq * 8;
#pragma unroll
        for (int ai = 0; ai < 2; ++ai) {
            EPI_GROUP(rb, row0 + ai * 128);
            u32x4 xv[4][2];
#pragma unroll
            for (int m = 0; m < 4; ++m)
#pragma unroll
                for (int bj = 0; bj < 2; ++bj) xv[m][bj] = *(const GAS u32x4*)(xb + (size_t)(rb + 16 * m) * DM + col0 + bj * 128);
#pragma unroll
            for (int m = 0; m < 4; ++m) {
                const int row = rb + 16 * m; float ss = 0.f;
#pragma unroll
                for (int bj = 0; bj < 2; ++bj) {
                    f32x4 xl, xh; unpack8(xv[m][bj], xl, xh);
                    const f32x4 x0 = xl + acc[ai][bj][m][0] * scale, x1 = xh + acc[ai][bj][m][1] * scale;
                    ss += (x0.x * x0.x + x0.y * x0.y) + (x0.z * x0.z + x0.w * x0.w) + (x1.x * x1.x + x1.y * x1.y) + (x1.z * x1.z + x1.w * x1.w);
                    u32x4 w; w.x = pk2(x0.x, x0.y); w.y = pk2(x0.z, x0.w); w.z = pk2(x1.x, x1.y); w.w = pk2(x1.z, x1.w);
                    *(GAS u32x4*)(xb + (size_t)row * DM + col0 + bj * 128) = w;
                }
                ss += __shfl_xor(ss, 16); ss += __shfl_xor(ss, 32);
                if (fq == 0) red[(row - u.pm * 256) * 4 + wc] = ss;
            }
        }
        asm volatile("s_waitcnt lgkmcnt(0)" ::: "memory"); __builtin_amdgcn_s_barrier(); asm volatile("" ::: "memory");
        { const int t = threadIdx.x; if (t < 256) { const f32x4 v = *(const LAS f32x4*)(red + 4 * t); ssq[(size_t)(u.pm * 256 + t) * 4 + u.pn] = (v.x + v.y) + (v.z + v.w); } }
        asm volatile("s_waitcnt lgkmcnt(0)" ::: "memory"); __builtin_amdgcn_s_barrier(); asm volatile("" ::: "memory");
    }
};
struct EpiIN {
    static constexpr bool PERM = true, AFTER_DRAIN = false;
    bf16* qkn; bf16* qkr; bf16* vt; bf16* gates; float* lf; float* widx; const float* ssq; const float* cosT; const float* sinT; const float* bfg; unsigned* kinf;
    __device__ __forceinline__ void operator()(AccRef acc, const pg8::Unit& u, int wr, int wc, int fr, int fq) const {
        const int row0 = u.pm * 256 + wr * 64 + fr, pn = u.pn;
        if (pn < 6) {
            const int d0 = 32 * (wc & 1) + 8 * fq;
            float r8[2][4]; rstd16x8(ssq, row0, r8);
            float kmx[2] = {0.f, 0.f};
#pragma unroll
            for (int ai = 0; ai < 2; ++ai) {
                EPI_GROUP(rb, row0 + ai * 128);
#pragma unroll
                for (int m = 0; m < 4; ++m) {
                    const int row = rb + 16 * m; const float r = r8[ai][m];
#pragma unroll
                    for (int bj = 0; bj < 2; ++bj) {
                        const int slot = 4 * pn + 2 * bj + (wc >> 1);
                        if (slot < 22) {
                            const float sc = r * (slot < 6 ? C2_64 : ((slot >= 12 && slot < 17) ? 0.125f : 1.0f));
                            float h[8];
#pragma unroll
                            for (int n = 0; n < 2; ++n)
#pragma unroll
                                for (int j = 0; j < 4; ++j) h[4 * n + j] = acc[ai][bj][m][n][j] * sc;
                            *(GAS u32x4*)(qkn + ((size_t)slot * MTOK + row) * 64 + d0) = pack8(h);
                            if (slot >= 6 && slot < 12) {
#pragma unroll
                                for (int e = 0; e < 8; ++e) kmx[bj] = fmaxf(kmx[bj], fabsf(h[e]));
                            }
                        }
                    }
                }
            }
#pragma unroll
            for (int bj = 0; bj < 2; ++bj) {
                const int slot = 4 * pn + 2 * bj + (wc >> 1);
                if (slot >= 6 && slot < 12) {
                    float v = kmx[bj];
#pragma unroll
                    for (int o = 1; o < 64; o <<= 1) v = fmaxf(v, __shfl_xor(v, o));
                    if ((threadIdx.x & 63) == 0) atomicMax(kinf + (u.pm >> 4) * 8 + (slot - 6), __float_as_uint(v * 1.01f));
                }
            }
        } else if (pn < 11) {
            const int hs = 4 * (pn - 6) + wc, i0 = 8 * fq;
            if (hs < 19) {
                const float scl = hs < 5 ? C2_64 : 1.0f;
#pragma unroll
                for (int ai = 0; ai < 2; ++ai) {
                    EPI_GROUP(rb, row0 + ai * 128);
                    f32x4 pq[4]; u32x4 csA[2][2], csB[2][2];
#pragma unroll
                    for (int m = 0; m < 4; ++m) pq[m] = *(const GAS f32x4*)(ssq + (size_t)(rb + 16 * m) * 4);
#pragma unroll
                    for (int mm = 0; mm < 2; ++mm)
#pragma unroll
                        for (int n = 0; n < 2; ++n) csA[mm][n] = *((const GAS u32x4*)((const unsigned*)cosT + (size_t)(rb + 16 * mm) * 32 + i0) + n);
                    float r4[4];
#pragma unroll
                    for (int m = 0; m < 4; ++m) r4[m] = __builtin_amdgcn_rsqf(((pq[m].x + pq[m].y) + (pq[m].z + pq[m].w)) * (1.0f / DM) + EPS);
#pragma unroll
                    for (int mm = 0; mm < 2; ++mm)
#pragma unroll
                        for (int n = 0; n < 2; ++n) csB[mm][n] = *((const GAS u32x4*)((const unsigned*)cosT + (size_t)(rb + 32 + 16 * mm) * 32 + i0) + n);
#pragma unroll
                    for (int m = 0; m < 4; ++m) {
                        const int row = rb + 16 * m; const float r = r4[m] * scl;
                        float o1[8], o2[8];
#pragma unroll
                        for (int n = 0; n < 2; ++n) { const u32x4 w = (m < 2) ? csA[m & 1][n] : csB[m & 1][n];
#pragma unroll
                            for (int j = 0; j < 4; ++j) { const float c = __uint_as_float(w[j] << 16), sn = __uint_as_float(w[j] & 0xffff0000u);
                                const float x1 = acc[ai][0][m][n][j] * r, x2 = acc[ai][1][m][n][j] * r; o1[4 * n + j] = x1 * c - x2 * sn; o2[4 * n + j] = x2 * c + x1 * sn; } }
                        if (hs == 18) {
                            bf16* dst = qkr + (size_t)18 * MTOK * 64 + (((size_t)(row >> 5) * 8 + fq) * 32 + (row & 31)) * 8;
                            *(GAS u32x4*)(dst) = pack8(o1); *(GAS u32x4*)(dst + 4 * 32 * 8) = pack8(o2);
                        } else {
                            bf16* dst = qkr + ((size_t)hs * MTOK + row) * 64 + i0;
                            *(GAS u32x4*)(dst) = pack8(o1); *(GAS u32x4*)(dst + 32) = pack8(o2);
                        }
                    }
                }
            } else {
                if (fq < 2) {
#pragma unroll
                    for (int ai = 0; ai < 2; ++ai) {
                        EPI_GROUP(rb, row0 + ai * 128); float r4[4]; rstd16x4(ssq, rb, r4);
#pragma unroll
                        for (int m = 0; m < 4; ++m) {
                            const int row = rb + 16 * m; const float r = r4[m];
#pragma unroll
                            for (int n = 0; n < 2; ++n)
#pragma unroll
                                for (int j = 0; j < 4; ++j) { const int i = 8 * fq + 4 * n + j; const float v = acc[ai][0][m][n][j] * r;
                                    if (i < 6) lf[(size_t)i * MTOK + row] = logsigmoidf_(v + bfg[i]);
                                    else if (i < 14) widx[(size_t)row * 8 + (i - 6)] = v * WIDX_SCALE; }
                        }
                    }
                }
            }
        } else if (pn < 15) {
            extern __shared__ __attribute__((aligned(16))) unsigned char lds_vt_[];
            LAS unsigned char* blk = (LAS unsigned char*)lds_vt_ + LDS_HIST + (wr * 4 + wc) * 1024;
            const int lane_ = fr + 16 * fq, tpf = tperm(fr);
            LAS unsigned char* wp = blk + (8 * fq) * 32 + tpf * 2;
            const LAS unsigned char* rp = blk + (lane_ >> 1) * 32 + (lane_ & 1) * 16;
            const int dsel = 32 * (wc & 1) + (lane_ >> 1);
#pragma unroll
            for (int ai = 0; ai < 2; ++ai) {
                EPI_GROUP(rb, row0 + ai * 128); float r4[4]; rstd16x4(ssq, rb, r4);
#pragma unroll
                for (int m = 0; m < 4; ++m) {
                    const float r = r4[m];
                    const int t0 = (rb - fr) + 16 * m, b = t0 >> 12, tp0 = t0 & 4095;
#pragma unroll
                    for (int bj = 0; bj < 2; ++bj) {
                        const int v = 4 * (pn - 11) + 2 * bj + (wc >> 1);
#pragma unroll
                        for (int n = 0; n < 2; ++n)
#pragma unroll
                            for (int j = 0; j < 4; ++j) *(LAS unsigned short*)(wp + (4 * n + j) * 32) = (unsigned short)(pk2(acc[ai][bj][m][n][j] * r, 0.f) & 0xffffu);
                        asm volatile("s_waitcnt lgkmcnt(0)" ::: "memory");
                        const u32x4 tv = *(const LAS u32x4*)rp;
                        asm volatile("s_waitcnt lgkmcnt(0)" ::: "memory");
                        *(GAS u32x4*)(vt + ((size_t)(v * 4 + b) * 64 + dsel) * SEQ + tp0 + 8 * (lane_ & 1)) = tv;
                    }
                }
            }
        } else {
            float r8[2][4]; rstd16x8(ssq, row0, r8);
            const int colb = 256 * (pn - 15) + 32 * wc + 8 * fq;
#pragma unroll
            for (int ai = 0; ai < 2; ++ai) {
                EPI_GROUP(rb, row0 + ai * 128);
#pragma unroll
                for (int m = 0; m < 4; ++m) {
                    const int row = rb + 16 * m; const float r = r8[ai][m];
#pragma unroll
                    for (int bj = 0; bj < 2; ++bj) {
                        float h[8];
#pragma unroll
                        for (int n = 0; n < 2; ++n)
#pragma unroll
                            for (int j = 0; j < 4; ++j) h[4 * n + j] = sigmoidf_(acc[ai][bj][m][n][j] * r);
                        *(GAS u32x4*)(gates + (size_t)row * 3072 + colb + 128 * bj) = pack8(h);
                    }
                }
            }
        }
    }
};
struct BranchOrder {
    pg8::StaticOrder S;
    __device__ __forceinline__ bool next(int i, pg8::Unit& u) const { pg8::Unit b; if (!S.next(i / 3, b)) return false; const int br = i % 3; u.pm = br * (MTOK / 256) + b.pm; u.pn = br * (DM / 256) + b.pn; return true; }
    __device__ __forceinline__ void a_ready(const pg8::Unit&) const {}
    __device__ __forceinline__ void done(const pg8::Unit&) const {}
};
struct EpiBR {
    static constexpr bool PERM = true, AFTER_DRAIN = false;
    const bf16* gates; float* mf; bf16* mb;
    __device__ __forceinline__ void operator()(AccRef acc, const pg8::Unit& u, int wr, int wc, int fr, int fq) const {
        const int mode = u.pn >> 2, pn = u.pn & 3, pm = u.pm & 63;
        const int row0 = pm * 256 + wr * 64 + fr, col0 = pn * 256 + wc * 32 + fq * 8;
#pragma unroll
        for (int ai = 0; ai < 2; ++ai) {
            EPI_GROUP(rb, row0 + ai * 128);
            u32x4 gv[4][2], pv[4][2];
#pragma unroll
            for (int m = 0; m < 4; ++m)
#pragma unroll
                for (int bj = 0; bj < 2; ++bj) { gv[m][bj] = *(const GAS u32x4*)(gates + (size_t)(rb + 16 * m) * 3072 + mode * DM + col0 + 128 * bj);
                    pv[m][bj] = (u32x4){0u, 0u, 0u, 0u}; if (mode > 0) pv[m][bj] = *(const GAS u32x4*)(mb + (size_t)(rb + 16 * m) * DM + col0 + 128 * bj); }
#pragma unroll
            for (int m = 0; m < 4; ++m)
#pragma unroll
                for (int bj = 0; bj < 2; ++bj) {
                    f32x4 g0, g1, p0, p1; unpack8(gv[m][bj], g0, g1); unpack8(pv[m][bj], p0, p1);
                    const f32x4 v0 = acc[ai][bj][m][0] * g0 + p0, v1 = acc[ai][bj][m][1] * g1 + p1;
                    u32x4 w; w.x = pk2(v0.x, v0.y); w.y = pk2(v0.z, v0.w); w.z = pk2(v1.x, v1.y); w.w = pk2(v1.z, v1.w);
                    *(GAS u32x4*)(mb + (size_t)(rb + 16 * m) * DM + col0 + 128 * bj) = w;
                }
        }
    }
};
struct EpiCQ {
    static constexpr bool PERM = true, AFTER_DRAIN = false;
    bf16* caq; const float* ssq;
    __device__ __forceinline__ void operator()(AccRef acc, const pg8::Unit& u, int wr, int wc, int fr, int fq) const {
        const int row0 = u.pm * 256 + wr * 64 + fr, d0 = 32 * wc + 8 * fq;
        float r8[2][4]; rstd16x8(ssq, row0, r8);
#pragma unroll
        for (int ai = 0; ai < 2; ++ai) {
            EPI_GROUP(rb, row0 + ai * 128);
#pragma unroll
            for (int m = 0; m < 4; ++m) {
                const int row = rb + 16 * m; const float r = r8[ai][m] * C2_128;
#pragma unroll
                for (int bj = 0; bj < 2; ++bj) {
                    float h[8];
#pragma unroll
                    for (int n = 0; n < 2; ++n)
#pragma unroll
                        for (int j = 0; j < 4; ++j) h[4 * n + j] = acc[ai][bj][m][n][j] * r;
                    *(GAS u32x4*)(caq + ((size_t)(2 * u.pn + bj) * MTOK + row) * 128 + d0) = pack8(h);
                }
            }
        }
    }
};
struct EpiCKV {
    static constexpr bool PERM = true, AFTER_DRAIN = false;
    bf16* mk; bf16* mvt; const float* memssq;
    __device__ __forceinline__ void operator()(AccRef acc, const pg8::Unit& u, int wr, int wc, int fr, int fq) const {
        const int b = u.pm, d0 = 32 * wc + 8 * fq, two = u.pn >> 1;
        float rr[2][4];
#pragma unroll
        for (int ai = 0; ai < 2; ++ai)
#pragma unroll
            for (int m = 0; m < 4; ++m) rr[ai][m] = *(const GAS float*)(memssq + b * 256 + ai * 128 + wr * 64 + m * 16 + fr);
#pragma unroll
        for (int ai = 0; ai < 2; ++ai)
#pragma unroll
            for (int m = 0; m < 4; ++m) rr[ai][m] = __builtin_amdgcn_rsqf(rr[ai][m] * (1.0f / DM) + EPS);
#pragma unroll
        for (int ai = 0; ai < 2; ++ai)
#pragma unroll
            for (int m = 0; m < 4; ++m) {
                int mrow = ai * 128 + wr * 64 + m * 16 + fr; asm volatile("" : "+v"(mrow)); const float r = rr[ai][m];
#pragma unroll
                for (int bj = 0; bj < 2; ++bj) {
                    const int h = 2 * (u.pn & 1) + bj;
                    if (!two) {
                        float hh[8];
#pragma unroll
                        for (int n = 0; n < 2; ++n)
#pragma unroll
                            for (int j = 0; j < 4; ++j) hh[4 * n + j] = acc[ai][bj][m][n][j] * r;
                        *(GAS u32x4*)(mk + ((size_t)(b * 4 + h) * 256 + mrow) * 128 + d0) = pack8(hh);
                    } else {
                        bf16* base = mvt + ((size_t)(b * 4 + h) * 128 + d0) * 256 + tperm(mrow);
#pragma unroll
                        for (int n = 0; n < 2; ++n)
#pragma unroll
                            for (int j = 0; j < 4; ++j) base[(size_t)(4 * n + j) * 256] = (bf16)(pk2(acc[ai][bj][m][n][j] * r, 0.f) & 0xffffu);
                    }
                }
            }
    }
};


__device__ __forceinline__ int srccol_gu(int n) { const int t = n >> 8, w = n & 255; return w < 128 ? 128 * t + w : DFF + 128 * t + (w - 128); }
__device__ __forceinline__ int srccol_in(int n) {
    const int pn = n >> 8, w = n & 255;
    if (pn < 6) { const int slot = 4 * pn + (w >> 6), d = w & 63;
        if (slot < 6) return 64 * slot + d; if (slot < 12) return 384 + 64 * (slot - 6) + d; if (slot < 17) return 2702 + 64 * (slot - 12) + d; if (slot < 22) return 3022 + 64 * (slot - 17) + d; return -1; }
    if (pn < 11) { const int bj = w >> 7, hs = 4 * (pn - 6) + ((w & 127) >> 5), i = w & 31, d = 32 * bj + i;
        if (hs < 5) return 1158 + 64 * hs + d; if (hs < 10) return 1478 + 64 * (hs - 5) + d; if (hs < 18) return 2118 + 64 * (hs - 10) + d; if (hs == 18) return 2630 + d;
        if (bj == 0) { if (i < 6) return 1152 + i; if (i < 14) return 2694 + (i - 6); }
        return -1; }
    if (pn < 15) { const int v = 4 * (pn - 11) + (w >> 6), d = w & 63;
        if (v < 6) return 768 + 64 * v + d; if (v < 11) return 1798 + 64 * (v - 6) + d; return 3342 + 64 * (v - 11) + d; }
    return 3662 + 256 * (pn - 15) + w;
}
template <int MAP>
__device__ __forceinline__ void conv_item(const float* W, int Ksrc, int Nsrc, bf16* WT, int Kdst, const float* gain, LAS float* scr, int kb, int nb, int lane) {
    const int k0 = 64 * kb, n0 = 32 * nb, n = n0 + (lane & 31);
    const int sc = MAP == 0 ? n : (MAP == 1 ? srccol_gu(n) : srccol_in(n));
    float v[32];
    const bool live = (sc >= 0) && (k0 < Ksrc);
    const GAS float* src = (const GAS float*)W + (size_t)(k0 + (lane >> 5)) * Nsrc + (live ? sc : 0);
#pragma unroll
    for (int i = 0; i < 32; ++i) v[i] = live ? src[(size_t)(2 * i) * Nsrc] : 0.f;
#pragma unroll
    for (int i = 0; i < 32; ++i) scr[(2 * i + (lane >> 5)) * 33 + (lane & 31)] = v[i];
    asm volatile("s_waitcnt lgkmcnt(0)" ::: "memory");
    const int c = lane & 7;
    f32x4 g0 = {1.f, 1.f, 1.f, 1.f}, g1 = g0;
    if (gain) { g0 = *(const GAS f32x4*)(gain + k0 + 8 * c); g1 = *(const GAS f32x4*)(gain + k0 + 8 * c + 4); }
#pragma unroll
    for (int j = 0; j < 4; ++j) { const int nn = (lane >> 3) + 8 * j; const LAS float* s = scr + (8 * c) * 33 + nn;
        u32x4 o; o.x = pk2(s[0 * 33] * g0.x, s[1 * 33] * g0.y); o.y = pk2(s[2 * 33] * g0.z, s[3 * 33] * g0.w); o.z = pk2(s[4 * 33] * g1.x, s[5 * 33] * g1.y); o.w = pk2(s[6 * 33] * g1.z, s[7 * 33] * g1.w);
        *(GAS u32x4*)(WT + (size_t)(n0 + nn) * Kdst + k0 + 8 * c) = o; }
    asm volatile("s_waitcnt lgkmcnt(0)" ::: "memory");
}
struct ConvMat { const float* W; const float* gain; bf16* WT; int Ksrc, Nsrc, Kdst, Ndst, map; };
__device__ __forceinline__ void conv_matrix(const ConvMat& cm, LAS float* scr, int gw, int NGW, int lane) {
    const int nblk = cm.Ndst / 32, nit = (cm.Kdst / 64) * nblk;
    for (int it = gw; it < nit; it += NGW) {
        const int kb = it / nblk, nb = it % nblk;
        if (cm.map == 0) conv_item<0>(cm.W, cm.Ksrc, cm.Nsrc, cm.WT, cm.Kdst, cm.gain, scr, kb, nb, lane);
        else if (cm.map == 1) conv_item<1>(cm.W, cm.Ksrc, cm.Nsrc, cm.WT, cm.Kdst, cm.gain, scr, kb, nb, lane);
        else conv_item<2>(cm.W, cm.Ksrc, cm.Nsrc, cm.WT, cm.Kdst, cm.gain, scr, kb, nb, lane);
    }
}

#define MFMA32(a, b, c) __builtin_amdgcn_mfma_f32_32x32x16_bf16((a), (b), (c), 0, 0, 0)
__device__ __forceinline__ int crow(int r, int hi) { return (r & 3) + 8 * (r >> 2) + 4 * hi; }

template <int NDT>
__device__ __forceinline__ void store_ot(bf16* Oh, int opitch, int q, int hi, const f32x16* o, float inv) {
#pragma unroll
    for (int dt = 0; dt < NDT; ++dt)
#pragma unroll
        for (int rp = 0; rp < 2; ++rp) {
            const int ra = 8 * rp, rb = 8 * rp + 4;
            const unsigned ax = pk2(o[dt][ra] * inv, o[dt][ra + 1] * inv), ay = pk2(o[dt][ra + 2] * inv, o[dt][ra + 3] * inv);
            const unsigned bx_ = pk2(o[dt][rb] * inv, o[dt][rb + 1] * inv), by_ = pk2(o[dt][rb + 2] * inv, o[dt][rb + 3] * inv);
            const auto sx = __builtin_amdgcn_permlane32_swap(ax, bx_, false, false), sy = __builtin_amdgcn_permlane32_swap(ay, by_, false, false);
            const u32x4 w = {sx[0], sy[0], sx[1], sy[1]};
            *(GAS u32x4*)(Oh + (size_t)q * opitch + 32 * dt + 8 * (2 * rp + hi)) = w;
        }
}

__device__ __forceinline__ float xhalf_max(float x) { const auto rr = __builtin_amdgcn_permlane32_swap(__float_as_uint(x), __float_as_uint(x), false, false); return fmaxf(__uint_as_float(rr[0]), __uint_as_float(rr[1])); }
__device__ __forceinline__ float xhalf_sumf(float x) { const auto rr = __builtin_amdgcn_permlane32_swap(__float_as_uint(x), __float_as_uint(x), false, false); return __uint_as_float(rr[0]) + __uint_as_float(rr[1]); }
__device__ __forceinline__ float xhalf_other(float x, int hi) { const auto rr = __builtin_amdgcn_permlane32_swap(__float_as_uint(x), __float_as_uint(x), false, false); return __uint_as_float(hi ? rr[0] : rr[1]); }

#ifndef DSA_ASM_BFE
#define DSA_ASM_BFE 1
#endif
#ifndef FOX_TERM_SLOT
#define FOX_TERM_SLOT 3
#endif
#ifndef RESCALE_THR
#define RESCALE_THR 5.0f
#endif
#ifndef DSA_MFMA_SUM
#define DSA_MFMA_SUM 1
#endif
template <int NDT> struct FlashState { float m, l; bool started; f32x16 o[NDT]; f32x16 ol; f32x16 negm; };

template <int D, int MODE>
__device__ __forceinline__ void flash_qk(f32x16& p0, f32x16& p1, const f32x16& negm, const LAS unsigned char* Tb, const int* koff, const bf16x8* qr, const int t, const int qw0, const int q, const int hi, const LAS float* ncl2) {
    constexpr int ND0 = D / 16;
    if (MODE == 0) {
#pragma unroll
        for (int rg = 0; rg < 4; ++rg) { const f32x4 c0 = *(const LAS f32x4*)(ncl2 + 64 * t + 8 * rg + 4 * hi), c1 = *(const LAS f32x4*)(ncl2 + 64 * t + 32 + 8 * rg + 4 * hi);
#pragma unroll
            for (int j = 0; j < 4; ++j) { p0[4 * rg + j] = c0[j]; p1[4 * rg + j] = c1[j]; } }
    } else {
#pragma unroll
        for (int r = 0; r < 16; ++r) { p0[r] = 0.f; p1[r] = 0.f; }
    }
#pragma unroll
    for (int d0 = 0; d0 < ND0; ++d0) {
        const bf16x8 kf0 = *(const LAS bf16x8*)(Tb + koff[d0]), kf1 = *(const LAS bf16x8*)(Tb + koff[d0] + 512);
        p0 = MFMA32(kf0, qr[d0], p0); p1 = MFMA32(kf1, qr[d0], p1);
        if (D == 128) __builtin_amdgcn_sched_barrier(0);
    }
    if (MODE == 0) {
        if (64 * t + 63 > qw0) {
#pragma unroll
            for (int r = 0; r < 16; ++r) { const int kv = 64 * t + crow(r, hi); if (kv > q) p0[r] = -INFINITY; if (kv + 32 > q) p1[r] = -INFINITY; }
        }
    }
}
template <int D, int MODE>
__device__ __forceinline__ void flash_sv(FlashState<D / 32>& S, f32x16& p0, f32x16& p1, const float mref, const LAS unsigned char* Tb, const int* voff, const int hi, const unsigned long long mw) {
    constexpr int NDT = D / 32;
    float mx = fmaxf(fmaxf(p0[0], p1[0]), fmaxf(p0[1], p1[1]));
#pragma unroll
    for (int r = 2; r < 16; r += 2) mx = fmaxf(fmaxf(mx, p0[r]), fmaxf(p1[r], fmaxf(p0[r + 1], p1[r + 1])));
    mx = xhalf_max(mx);
    const float rel = mx - S.m; (void)mref;
    const float dl = S.started ? (rel > RESCALE_THR ? rel : 0.f) : rel;
    bool skip = false;
    if (MODE == 0) skip = S.started && __all(rel < -150.0f);
    S.started = true;
    if (skip) return;
    if (__any(dl != 0.f)) {
        const float alpha = fexp2(-dl); S.m += dl;
#pragma unroll
        for (int dt = 0; dt < NDT; ++dt)
#pragma unroll
            for (int r = 0; r < 16; ++r) S.o[dt][r] *= alpha;
        if (MODE == 1) S.l *= alpha;
        else {
#pragma unroll
            for (int r = 0; r < 16; ++r) S.ol[r] *= alpha;
        }
    }
    { const float m = S.m;
#pragma unroll
        for (int r = 0; r < 16; ++r) { p0[r] = fexp2(p0[r] - m); p1[r] = fexp2(p1[r] - m); }
    }
    if (MODE == 1) {
        const unsigned wlo = ((unsigned)mw) >> (4 * hi), whi = ((unsigned)(mw >> 32)) >> (4 * hi);
#pragma unroll
        for (int r = 0; r < 16; ++r) { const int bit = 8 * (r >> 2) + (r & 3);
            p0[r] = __uint_as_float(__float_as_uint(p0[r]) & (unsigned)__builtin_amdgcn_sbfe((int)wlo, bit, 1));
            p1[r] = __uint_as_float(__float_as_uint(p1[r]) & (unsigned)__builtin_amdgcn_sbfe((int)whi, bit, 1)); }
    }
    if (MODE == 1) { float rs = 0.f;
#pragma unroll
        for (int r = 0; r < 16; ++r) rs += p0[r] + p1[r];
        S.l += rs; }
    u32x4 pw[4];
#pragma unroll
    for (int s = 0; s < 2; ++s) {
        pw[s] = (u32x4){pk2(p0[8 * s], p0[8 * s + 1]), pk2(p0[8 * s + 2], p0[8 * s + 3]), pk2(p0[8 * s + 4], p0[8 * s + 5]), pk2(p0[8 * s + 6], p0[8 * s + 7])};
        pw[2 + s] = (u32x4){pk2(p1[8 * s], p1[8 * s + 1]), pk2(p1[8 * s + 2], p1[8 * s + 3]), pk2(p1[8 * s + 4], p1[8 * s + 5]), pk2(p1[8 * s + 6], p1[8 * s + 7])};
    }
#pragma unroll
    for (int g = 0; g < 4; ++g)
#pragma unroll
        for (int dt = 0; dt < NDT; ++dt) {
            const bf16x8 vf = *(const LAS bf16x8*)(Tb + D * 128 + voff[g] + 512 * dt);
            S.o[dt] = MFMA32(vf, __builtin_bit_cast(bf16x8, pw[g]), S.o[dt]);
            if (D == 128) __builtin_amdgcn_sched_barrier(0);
        }
    if (MODE != 1) {
        const unsigned one2 = ((threadIdx.x & 31) == 0) ? 0x3f803f80u : 0u;
        const bf16x8 vones = __builtin_bit_cast(bf16x8, (u32x4){one2, one2, one2, one2});
#pragma unroll
        for (int g = 0; g < 4; ++g) S.ol = MFMA32(vones, __builtin_bit_cast(bf16x8, pw[g]), S.ol);
    }
}

template <int MODE>
__device__ __forceinline__ void flash_tile3(FlashState<2>& S, bf16x8 (&kf)[8], const LAS unsigned char* Tb, const LAS unsigned char* Tn, const bool next_act, const int* koff, const bf16x8* qr,
                                            const int t, const int qw0, const int q, const int hi, const unsigned long long mw, const LAS float* ncl2, const bool act) {
    bool do_pv = false; u32x4 pw[4]; bf16x8 vf[8];
    if (act) {
        f32x16 p0, p1;
        if (MODE == 0) {
#pragma unroll
            for (int rg = 0; rg < 4; ++rg) { const f32x4 c0 = *(const LAS f32x4*)(ncl2 + 64 * t + 8 * rg + 4 * hi), c1 = *(const LAS f32x4*)(ncl2 + 64 * t + 32 + 8 * rg + 4 * hi);
#pragma unroll
                for (int j = 0; j < 4; ++j) { p0[4 * rg + j] = c0[j]; p1[4 * rg + j] = c1[j]; } }
        } else {
#pragma unroll
            for (int r = 0; r < 16; ++r) { p0[r] = 0.f; p1[r] = 0.f; }
        }
#pragma unroll
        for (int d0 = 0; d0 < 4; ++d0) { p0 = MFMA32(kf[2 * d0], qr[d0], p0); p1 = MFMA32(kf[2 * d0 + 1], qr[d0], p1); }
        if (MODE == 0) {
            if (64 * t + 63 > qw0) {
#pragma unroll
                for (int r = 0; r < 16; ++r) { const int kv = 64 * t + crow(r, hi); if (kv > q) p0[r] = -INFINITY; if (kv + 32 > q) p1[r] = -INFINITY; }
            }
        }
        float mx = fmaxf(fmaxf(p0[0], p1[0]), fmaxf(p0[1], p1[1]));
#pragma unroll
        for (int r = 2; r < 16; r += 2) mx = fmaxf(fmaxf(mx, p0[r]), fmaxf(p1[r], fmaxf(p0[r + 1], p1[r + 1])));
        mx = xhalf_max(mx);
        const float rel = mx - S.m;
        const float dl = S.started ? (rel > RESCALE_THR ? rel : 0.f) : rel;
        bool skip = false;
        if (MODE == 0) skip = S.started && __all(rel < -150.0f);
        S.started = true;
        if (!skip) {
            do_pv = true;
#pragma unroll
            for (int g = 0; g < 4; ++g) { vf[2 * g] = *(const LAS bf16x8*)(Tb + 8192 + koff[g]); vf[2 * g + 1] = *(const LAS bf16x8*)(Tb + 8192 + koff[g] + 512); }
            __builtin_amdgcn_sched_barrier(0);
            if (__any(dl != 0.f)) {
                const float alpha = fexp2(-dl); S.m += dl;
#pragma unroll
                for (int dt = 0; dt < 2; ++dt)
#pragma unroll
                    for (int r = 0; r < 16; ++r) S.o[dt][r] *= alpha;
                if (MODE == 1 && !DSA_MFMA_SUM) S.l *= alpha;
                else {
#pragma unroll
                    for (int r = 0; r < 16; ++r) S.ol[r] *= alpha;
                }
            }
            { const float m = S.m;
#pragma unroll
                for (int r = 0; r < 16; ++r) { p0[r] = fexp2(p0[r] - m); p1[r] = fexp2(p1[r] - m); } }
            if (MODE == 1) {
                const unsigned wlo = ((unsigned)mw) >> (4 * hi), whi = ((unsigned)(mw >> 32)) >> (4 * hi);
#pragma unroll
                for (int r = 0; r < 16; ++r) { const int bit = 8 * (r >> 2) + (r & 3);
#if DSA_ASM_BFE
                    unsigned t0, t1;
                    asm("v_bfe_i32 %0, %1, %2, 1" : "=v"(t0) : "v"(wlo), "n"(bit));
                    asm("v_bfe_i32 %0, %1, %2, 1" : "=v"(t1) : "v"(whi), "n"(bit));
                    p0[r] = __uint_as_float(__float_as_uint(p0[r]) & t0);
                    p1[r] = __uint_as_float(__float_as_uint(p1[r]) & t1); }
#else
                    p0[r] = __uint_as_float(__float_as_uint(p0[r]) & (unsigned)__builtin_amdgcn_sbfe((int)wlo, bit, 1));
                    p1[r] = __uint_as_float(__float_as_uint(p1[r]) & (unsigned)__builtin_amdgcn_sbfe((int)whi, bit, 1)); }
#endif
#if !DSA_MFMA_SUM
                float rs = 0.f;
#pragma unroll
                for (int r = 0; r < 16; ++r) rs += p0[r] + p1[r];
                S.l += rs;
#endif
            }
#pragma unroll
            for (int s = 0; s < 2; ++s) {
                pw[s] = (u32x4){pk2(p0[8 * s], p0[8 * s + 1]), pk2(p0[8 * s + 2], p0[8 * s + 3]), pk2(p0[8 * s + 4], p0[8 * s + 5]), pk2(p0[8 * s + 6], p0[8 * s + 7])};
                pw[2 + s] = (u32x4){pk2(p1[8 * s], p1[8 * s + 1]), pk2(p1[8 * s + 2], p1[8 * s + 3]), pk2(p1[8 * s + 4], p1[8 * s + 5]), pk2(p1[8 * s + 6], p1[8 * s + 7])};
            }
        }
    }
    if (next_act) {
#pragma unroll
        for (int d0 = 0; d0 < 4; ++d0) { kf[2 * d0] = *(const LAS bf16x8*)(Tn + koff[d0]); kf[2 * d0 + 1] = *(const LAS bf16x8*)(Tn + koff[d0] + 512); }
    }
    __builtin_amdgcn_sched_barrier(0);
    if (do_pv) {
#pragma unroll
        for (int g = 0; g < 4; ++g) { S.o[0] = MFMA32(vf[2 * g], __builtin_bit_cast(bf16x8, pw[g]), S.o[0]); S.o[1] = MFMA32(vf[2 * g + 1], __builtin_bit_cast(bf16x8, pw[g]), S.o[1]); }
        if (MODE != 1 || DSA_MFMA_SUM) {
            const unsigned one2 = ((threadIdx.x & 31) == 0) ? 0x3f803f80u : 0u;
            const bf16x8 vones = __builtin_bit_cast(bf16x8, (u32x4){one2, one2, one2, one2});
#pragma unroll
            for (int g = 0; g < 4; ++g) S.ol = MFMA32(vones, __builtin_bit_cast(bf16x8, pw[g]), S.ol);
        }
    }
}

template <int D, int MODE>
__device__ __forceinline__ void flash_unit(LAS unsigned char* lds, const bf16* Qh, const bf16* Kh, const bf16* VTh, const int vtp, bf16* Oh, const int opitch,
                                           const int q0, const int NT, const unsigned long long* mrow, const LAS float* ncl2, const float kinf = 0.f) {
    constexpr int KB = D * 128, NCH = D / 64, ND0 = D / 16, NDT = D / 32, CPR = D / 8;
    int tid_ = threadIdx.x; asm volatile("" : "+v"(tid_)); const int tid = tid_, lane = tid & 63, r32 = lane & 31, hi = lane >> 5, wid = __builtin_amdgcn_readfirstlane(tid >> 6);
    const int qw0 = q0 + 32 * wid, q = qw0 + r32;
    bf16x8 qr[ND0];
#pragma unroll
    for (int d0 = 0; d0 < ND0; ++d0) qr[d0] = *(const GAS bf16x8*)(Qh + (size_t)q * D + 16 * d0 + 8 * hi);
    unsigned ksrc[NCH], vsrc[NCH]; int kdst[NCH], vdst[NCH];
#pragma unroll
    for (int j = 0; j < NCH; ++j) { const int idx = tid + 512 * j; const int c = idx % CPR, kv = idx / CPR, cc = idx & 7, d = idx >> 3;
        ksrc[j] = (unsigned)(kv * D + 8 * c) * 2u; kdst[j] = c * 1024 + ((kv ^ (2 * c)) & 63) * 16; vsrc[j] = (unsigned)(d * vtp + 8 * cc) * 2u; vdst[j] = KB + cc * (D * 16) + (d ^ (2 * cc)) * 16; }
    int koff[ND0], voff_[D == 64 ? 1 : 4];
#pragma unroll
    for (int d0 = 0; d0 < ND0; ++d0) koff[d0] = (2 * d0 + hi) * 1024 + ((r32 ^ (4 * d0 + 2 * hi)) & 63) * 16;
    if (D != 64) {
#pragma unroll
        for (int g = 0; g < 4; ++g) voff_[D == 64 ? 0 : g] = (2 * g + hi) * (D * 16) + (r32 ^ (4 * g + 2 * hi)) * 16;
    }
    const int* voff = (D == 64) ? koff : voff_;
#define FL_TILE(i) ((MODE == 0) ? (NT - 1 - (i)) : (i))
#define FL_ACT(i) ((MODE != 0) || (64 * FL_TILE(i) <= qw0 + 31))
#define FL_LOAD(KR, VR, i) do { const int t_ = FL_TILE(i); const GAS char* kb_ = (const GAS char*)(Kh + (size_t)t_ * 64 * D); const GAS char* vb_ = (const GAS char*)(VTh + (size_t)t_ * 64); \
        _Pragma("unroll") for (int j_ = 0; j_ < NCH; ++j_) { KR[j_] = *(const GAS u32x4*)(kb_ + ksrc[j_]); VR[j_] = *(const GAS u32x4*)(vb_ + vsrc[j_]); } } while (0)
#define FL_STORE(KR, VR, b) do { _Pragma("unroll") for (int j_ = 0; j_ < NCH; ++j_) { *(LAS u32x4*)(lds + (b) * 2 * KB + kdst[j_]) = KR[j_]; *(LAS u32x4*)(lds + (b) * 2 * KB + vdst[j_]) = VR[j_]; } } while (0)
    FlashState<NDT> S; S.m = 0.f; S.l = 0.f; S.started = false;
#pragma unroll
    for (int r = 0; r < 16; ++r) { S.ol[r] = 0.f; S.negm[r] = 0.f; }
#pragma unroll
    for (int dt = 0; dt < NDT; ++dt)
#pragma unroll
        for (int r = 0; r < 16; ++r) S.o[dt][r] = 0.f;
    const unsigned mqo = (unsigned)q * 512u;
#define MQ(i) (*(const GAS unsigned long long*)((const GAS char*)mrow + (size_t)(i) * 8 + mqo))
    if constexpr (MODE == 2) {
        u32x4 kr[NCH], vr[NCH];
        for (int t = 0; t < NT; ++t) { FL_LOAD(kr, vr, t); FL_STORE(kr, vr, t); }
        __syncthreads();
        for (int t = 0; t < NT; ++t) { f32x16 p0, p1; const float mr = S.m; flash_qk<D, MODE>(p0, p1, S.negm, lds + t * 2 * KB, koff, qr, t, qw0, q, hi, ncl2); flash_sv<D, MODE>(S, p0, p1, mr, lds + t * 2 * KB, voff, hi, 0ull); }
        __syncthreads();
    } else {
        u32x4 kE[NCH], vE[NCH], kO[NCH], vO[NCH];
        unsigned long long wE = 0ull, wO = 0ull;
        bf16x8 kf[8];
        float qbound = 0.f; bool stop = false;
        LAS int* tflags = (LAS int*)(lds + 65536 + 16384 + 64);
        if (MODE == 0) { float s1 = 0.f;
#pragma unroll
            for (int d0 = 0; d0 < ND0; ++d0)
#pragma unroll
                for (int e = 0; e < 8; ++e) s1 += __uint_as_float(((unsigned)(unsigned short)qr[d0][e] & 0x7fffu) << 16);
            qbound = xhalf_sumf(s1) * kinf; }
        if (wid & 4) __builtin_amdgcn_s_setprio(1);
        FL_LOAD(kE, vE, 0); if (MODE == 1) wE = MQ(0);
        if (1 < NT) { FL_LOAD(kO, vO, 1); if (MODE == 1) wO = MQ(1); }
        FL_STORE(kE, vE, 0);
        if (1 < NT) FL_STORE(kO, vO, 1);
        if (2 < NT) FL_LOAD(kE, vE, 2);
        if (3 < NT) FL_LOAD(kO, vO, 3);
        __syncthreads();
        if (FL_ACT(0)) {
#pragma unroll
            for (int d0 = 0; d0 < 4; ++d0) { kf[2 * d0] = *(const LAS bf16x8*)(lds + koff[d0]); kf[2 * d0 + 1] = *(const LAS bf16x8*)(lds + koff[d0] + 512); }
        }
#define FL_STEP(i, SL, KP, VP, WL) do { \
            const unsigned long long mwc_ = WL; \
            if (MODE == 1) { if ((i) + 2 < NT) WL = MQ((i) + 2); } \
            { const bool nact_ = ((i) + 1 < NT) && FL_ACT((i) + 1); \
              flash_tile3<MODE>(S, kf, lds + (SL) * 2 * KB, lds + (((SL) + 1) & 3) * 2 * KB, nact_, koff, qr, FL_TILE(i), qw0, q, hi, mwc_, ncl2, FL_ACT(i)); } \
            if ((i) + 2 < NT) FL_STORE(KP, VP, ((SL) + 2) & 3);                                      \
            if ((i) + 4 < NT) FL_LOAD(KP, VP, (i) + 4);                                              \
            if (MODE == 0 && (SL) == FOX_TERM_SLOT) { const int t_ = FL_TILE(i); bool dead_ = false; \
                if (t_ > 0 && S.started) dead_ = __all(qbound + ncl2[64 * t_ - 1] - S.m < -150.0f); \
                if (lane == 0) tflags[(SL) * 8 + wid] = dead_ ? 1 : 0; } \
            __syncthreads(); \
            if (MODE == 0 && (SL) == FOX_TERM_SLOT) { const LAS int* fl_ = tflags + (SL) * 8; stop = (fl_[0] & fl_[1] & fl_[2] & fl_[3] & fl_[4] & fl_[5] & fl_[6] & fl_[7]) != 0; } \
            } while (0)
        for (int it = 0; it < NT; it += 4) {
            FL_STEP(it, 0, kE, vE, wE);
            if (stop || it + 1 >= NT) break;
            FL_STEP(it + 1, 1, kO, vO, wO);
            if (stop || it + 2 >= NT) break;
            FL_STEP(it + 2, 2, kE, vE, wE);
            if (stop || it + 3 >= NT) break;
            FL_STEP(it + 3, 3, kO, vO, wO);
            if (stop) break;
        }
        __builtin_amdgcn_s_setprio(0);
#undef FL_STEP
    }
    const float l = xhalf_sumf((MODE == 1 && !DSA_MFMA_SUM) ? S.l : (hi == 0 ? S.ol[0] : 0.f));
    store_ot<NDT>(Oh, opitch, q, hi, S.o, frcp(l));
#undef FL_LOAD
#undef FL_STORE
#undef FL_TILE
#undef FL_ACT
#undef MQ
}

__device__ __forceinline__ void sb_tile(float& carry, f32x16* o, const LAS unsigned char* Tb, const int* koff, const int* voff, const bf16x8* qr, const int j, const int q, const int hi, const int qw0) {
    f32x16 p0, p1;
#pragma unroll
    for (int r = 0; r < 16; ++r) { p0[r] = 0.f; p1[r] = 0.f; }
#pragma unroll
    for (int d0 = 0; d0 < 4; ++d0) {
        const bf16x8 kf0 = *(const LAS bf16x8*)(Tb + koff[d0]), kf1 = *(const LAS bf16x8*)(Tb + koff[d0] + 512);
        p0 = MFMA32(kf0, qr[d0], p0); p1 = MFMA32(kf1, qr[d0], p1);
    }
    float x[32], lb[32];
#pragma unroll
    for (int e = 0; e < 32; ++e) {
        const float z = e < 16 ? p0[e & 15] : p1[e & 15];
        const float lbv = logsigmoidf_(z);
        x[e] = lbv - z; lb[e] = lbv;
    }
    if (64 * j + 63 >= qw0) {
#pragma unroll
        for (int e = 0; e < 32; ++e) { const int kv = 64 * j + 32 * (e >> 4) + crow(e & 15, hi); if (!(kv < q)) { x[e] = 0.f; lb[e] = -INFINITY; } }
    }
    float gs[8], pr[8];
#pragma unroll
    for (int gl = 0; gl < 8; ++gl) gs[gl] = (x[4 * gl] + x[4 * gl + 1]) + (x[4 * gl + 2] + x[4 * gl + 3]);
#pragma unroll
    for (int gl = 0; gl < 8; ++gl) pr[gl] = xhalf_other(gs[gl], hi);
    float run = carry;
#pragma unroll
    for (int gl = 7; gl >= 0; --gl) {
        const float sg = run + (hi == 0 ? pr[gl] : 0.f);
        const float s3 = sg, s2 = s3 + x[4 * gl + 3], s1 = s2 + x[4 * gl + 2], s0 = s1 + x[4 * gl + 1];
        x[4 * gl + 3] = fexp2((lb[4 * gl + 3] + s3) * LOG2E); x[4 * gl + 2] = fexp2((lb[4 * gl + 2] + s2) * LOG2E);
        x[4 * gl + 1] = fexp2((lb[4 * gl + 1] + s1) * LOG2E); x[4 * gl] = fexp2((lb[4 * gl] + s0) * LOG2E);
        run += gs[gl] + pr[gl];
    }
    carry = run;
    u32x4 pw[4];
#pragma unroll
    for (int g = 0; g < 4; ++g) pw[g] = (u32x4){pk2(x[8 * g], x[8 * g + 1]), pk2(x[8 * g + 2], x[8 * g + 3]), pk2(x[8 * g + 4], x[8 * g + 5]), pk2(x[8 * g + 6], x[8 * g + 7])};
#pragma unroll
    for (int g = 0; g < 4; ++g)
#pragma unroll
        for (int dt = 0; dt < 2; ++dt) {
            const bf16x8 vf = *(const LAS bf16x8*)(Tb + 8192 + voff[g] + 512 * dt);
            o[dt] = MFMA32(vf, __builtin_bit_cast(bf16x8, pw[g]), o[dt]);
        }
}
__device__ __forceinline__ void sb_unit(LAS unsigned char* lds, const bf16* Qh, const bf16* Kh, const bf16* VTh, bf16* Oh, const int q0) {
    constexpr int D = 64, KB = 8192;
    int tid_ = threadIdx.x; asm volatile("" : "+v"(tid_)); const int tid = tid_, lane = tid & 63, r32 = lane & 31, hi = lane >> 5, wid = __builtin_amdgcn_readfirstlane(tid >> 6);
    const int qw0 = q0 + 32 * wid, q = qw0 + r32;
    bf16x8 qr[4];
#pragma unroll
    for (int d0 = 0; d0 < 4; ++d0) qr[d0] = *(const GAS bf16x8*)(Qh + (size_t)q * D + 16 * d0 + 8 * hi);
    const int c_ = tid & 7, kv_ = tid >> 3;
    const unsigned ksrc = (unsigned)(kv_ * D + 8 * c_) * 2u; const int kdst = c_ * 1024 + ((kv_ ^ (2 * c_)) & 63) * 16;
    const unsigned vsrc = (unsigned)(kv_ * SEQ + 8 * c_) * 2u; const int vdst = KB + c_ * (D * 16) + (kv_ ^ (2 * c_)) * 16;
    int koff[4];
#pragma unroll
    for (int d0 = 0; d0 < 4; ++d0) koff[d0] = (2 * d0 + hi) * 1024 + ((r32 ^ (4 * d0 + 2 * hi)) & 63) * 16;
    const int* voff = koff;
    LAS int* flags = (LAS int*)(lds + 4 * KB);
    u32x4 kreg, vreg;
#define SB_LOAD(t) do { kreg = *(const GAS u32x4*)((const GAS char*)(Kh + (size_t)(t) * 64 * D) + ksrc); vreg = *(const GAS u32x4*)((const GAS char*)(VTh + (size_t)(t) * 64) + vsrc); } while (0)
#define SB_STORE(b) do { *(LAS u32x4*)(lds + (b) * 2 * KB + kdst) = kreg; *(LAS u32x4*)(lds + (b) * 2 * KB + vdst) = vreg; } while (0)
    float carry = 0.f; bool wdone = false; f32x16 o[2];
#pragma unroll
    for (int dt = 0; dt < 2; ++dt)
#pragma unroll
        for (int r = 0; r < 16; ++r) o[dt][r] = 0.f;
    const int jtop = (q0 >> 6) + 3;
    SB_LOAD(jtop); SB_STORE(0); __syncthreads();
    int it = 0;
    for (int j = jtop; j >= 0; --j, ++it) {
        const int buf = it & 1;
        if (j > 0) SB_LOAD(j - 1);
        const bool started = (64 * j <= qw0);
        if (started && !wdone) sb_tile(carry, o, lds + buf * 2 * KB, koff, voff, qr, j, q, hi, qw0);
        wdone = started && __all(carry < -104.0f);
        const bool done = wdone;
        if (buf && lane == 0) flags[wid] = done ? 1 : 0;
        if (j > 0) SB_STORE(buf ^ 1);
        __syncthreads();
        if (buf) {
            const int alld = flags[0] & flags[1] & flags[2] & flags[3] & flags[4] & flags[5] & flags[6] & flags[7];
            if (alld) break;
        }
    }
    store_ot<2>(Oh, 384, q, hi, o, 1.0f);
    __syncthreads();
#undef SB_LOAD
#undef SB_STORE
}

__device__ __forceinline__ unsigned fkey(float x) { const unsigned b = __float_as_uint(x); return b ^ ((unsigned)((int)b >> 31) | 0x80000000u); }
__device__ __forceinline__ float xhalf_sum(float x) { const auto rr = __builtin_amdgcn_permlane32_swap(__float_as_uint(x), __float_as_uint(x), false, false); return __uint_as_float(rr[0]) + __uint_as_float(rr[1]); }
__device__ __forceinline__ unsigned wave_sum_u32(unsigned v) {
    unsigned x = v;
    x += (unsigned)__builtin_amdgcn_update_dpp(0, (int)x, 0x111, 0xf, 0xf, true);
    x += (unsigned)__builtin_amdgcn_update_dpp(0, (int)x, 0x112, 0xf, 0xf, true);
    x += (unsigned)__builtin_amdgcn_update_dpp(0, (int)x, 0x114, 0xf, 0xf, true);
    x += (unsigned)__builtin_amdgcn_update_dpp(0, (int)x, 0x118, 0xf, 0xf, true);
    return (unsigned)__builtin_amdgcn_readlane((int)x, 15) + (unsigned)__builtin_amdgcn_readlane((int)x, 31) + (unsigned)__builtin_amdgcn_readlane((int)x, 47) + (unsigned)__builtin_amdgcn_readlane((int)x, 63);
}
typedef short s16x2 __attribute__((ext_vector_type(2)));
#define IDX_SCORES(KB_) do { const int key = 32 * s + r32; \
        f32x16 y_; _Pragma("unroll") for (int r = 0; r < 16; ++r) y_[r] = 0.f; \
        f32x16 acc_[2]; _Pragma("unroll") for (int r = 0; r < 16; ++r) { acc_[0][r] = 0.f; acc_[1][r] = 0.f; } \
          \
        _Pragma("unroll") for (int d0 = 0; d0 < 4; ++d0) { acc_[0] = MFMA32(qa[0][d0], KB_[d0], acc_[0]); acc_[1] = MFMA32(qa[1][d0], KB_[d0], acc_[1]); } \
        __builtin_amdgcn_sched_barrier(0); \
        _Pragma("unroll") for (int rt = 0; rt < 2; ++rt) { \
            _Pragma("unroll") for (int s2 = 0; s2 < 2; ++s2) { u32x4 xp; \
                _Pragma("unroll") for (int jj = 0; jj < 4; ++jj) { const s16x2 pz = {0, 0}; \
                    const unsigned pkd = pk2(acc_[rt][8 * s2 + 2 * jj], acc_[rt][8 * s2 + 2 * jj + 1]); \
                    xp[jj] = __builtin_bit_cast(unsigned, __builtin_elementwise_max(__builtin_bit_cast(s16x2, pkd), pz)); } \
                y_ = MFMA32(wf[rt][s2], __builtin_bit_cast(bf16x8, xp), y_); } \
        } \
        if (32 * s + 31 > t0) {         \
            _Pragma("unroll") for (int r = 0; r < 4; ++r) if (key > t0 + 4 * hi + r) y_[r] = __uint_as_float(0xffffffffu); } \
        _Pragma("unroll") for (int r = 0; r < 4; ++r) sc[(4 * hi + r) * 4096 + key] = y_[r]; \
        } while (0)
struct IdxPre { bf16x8 k0[4], k1[4], k2[4]; bf16x8 qa[2][4]; f32x4 w0, w1; };
#define IDX_KLOAD(KR, ss) do { if ((ss) < nsub) { _Pragma("unroll") for (int d0 = 0; d0 < 4; ++d0) KR[d0] = *(const GAS bf16x8*)(kbase + (size_t)(ss) * 2048 + 512 * d0); } } while (0)
__device__ __forceinline__ void idx_preload(IdxPre& P, const bf16* QI, const bf16* KI, const float* WI, const int b, const int t0) {
    int tid_ = threadIdx.x; asm volatile("" : "+v"(tid_)); const int tid = tid_, lane = tid & 63, r32 = lane & 31, hi = lane >> 5, wid = __builtin_amdgcn_readfirstlane(tid >> 6);
    const int nk = t0 + 8, nsub = ((nk + 63) >> 6) * 2;
    const size_t tok0 = (size_t)b * SEQ + t0;
    const bf16* kbase = KI + ((size_t)b * 128 * 8 + hi) * 256 + (size_t)r32 * 8;
#define IDX_KLOADZ(KR, ss) do { if ((ss) < nsub) { _Pragma("unroll") for (int d0 = 0; d0 < 4; ++d0) KR[d0] = *(const GAS bf16x8*)(kbase + (size_t)(ss) * 2048 + 512 * d0); } \
        else { _Pragma("unroll") for (int d0 = 0; d0 < 4; ++d0) KR[d0] = (bf16x8){0, 0, 0, 0, 0, 0, 0, 0}; } } while (0)
    IDX_KLOADZ(P.k0, wid); IDX_KLOADZ(P.k1, wid + 8); IDX_KLOADZ(P.k2, wid + 16);
#undef IDX_KLOADZ
    const int h = r32 >> 2, qq = r32 & 3, qp = r32 & 7;
#pragma unroll
    for (int rt = 0; rt < 2; ++rt)
#pragma unroll
        for (int d0 = 0; d0 < 4; ++d0) P.qa[rt][d0] = *(const GAS bf16x8*)(QI + ((size_t)h * MTOK + tok0 + 4 * rt + qq) * 64 + 16 * d0 + 8 * hi);
    P.w0 = *(const GAS f32x4*)(WI + (tok0 + qp) * 8); P.w1 = *(const GAS f32x4*)(WI + (tok0 + qp) * 8 + 4);
}
__device__ __forceinline__ void idx_unit(LAS unsigned char* lds, IdxPre& P, const bf16* QI, const bf16* KI, const float* WI, unsigned long long* MASK, const int b, const int t0,
                                         const bool has_next, const int nb, const int nt0, const int what = 3) {
    int tid_ = threadIdx.x; asm volatile("" : "+v"(tid_)); const int tid = tid_, lane = tid & 63, r32 = lane & 31, hi = lane >> 5, wid = __builtin_amdgcn_readfirstlane(tid >> 6);
    LAS float* sc = (LAS float*)lds;
    const int nk = t0 + 8, nsub = ((nk + 63) >> 6) * 2;
    if (what & 1) {
        const bf16* kbase = KI + ((size_t)b * 128 * 8 + hi) * 256 + (size_t)r32 * 8;
        bf16x8 k0[4], k1[4], k2[4], k3_[4];
#pragma unroll
        for (int d0 = 0; d0 < 4; ++d0) { k0[d0] = P.k0[d0]; k1[d0] = P.k1[d0]; k2[d0] = P.k2[d0]; }
        int s = wid;
        bf16x8 qa[2][4]; bf16x8 wf[2][2];
#pragma unroll
        for (int rt = 0; rt < 2; ++rt)
#pragma unroll
            for (int d0 = 0; d0 < 4; ++d0) qa[rt][d0] = P.qa[rt][d0];
        { const int qp = r32 & 7;
          const f32x4 w0 = P.w0, w1 = P.w1;
          const float wh[2][2] = {{hi ? w0.y : w0.x, hi ? w0.w : w0.z}, {hi ? w1.y : w1.x, hi ? w1.w : w1.z}};
#pragma unroll
          for (int rt = 0; rt < 2; ++rt)
#pragma unroll
              for (int s2 = 0; s2 < 2; ++s2) { u32x4 f = {0u, 0u, 0u, 0u};
                  if (r32 < 8 && (qp >> 2) == rt) { const int q0_ = qp & 3;
#pragma unroll
                      for (int j = 0; j < 8; ++j) if ((j & 3) == q0_) { const unsigned bits = pk2(wh[s2][j >> 2], 0.f) & 0xffffu; f[j >> 1] |= (j & 1) ? (bits << 16) : bits; } }
                  wf[rt][s2] = __builtin_bit_cast(bf16x8, f); }
        }
        while (s < nsub) {
            IDX_KLOAD(k3_, s + 24); IDX_SCORES(k0); s += 8; if (s >= nsub) break;
            IDX_KLOAD(k0, s + 24); IDX_SCORES(k1); s += 8; if (s >= nsub) break;
            IDX_KLOAD(k1, s + 24); IDX_SCORES(k2); s += 8; if (s >= nsub) break;
            IDX_KLOAD(k2, s + 24); IDX_SCORES(k3_); s += 8;
        }
    }
    __syncthreads();
    for (int rs_ = 0; rs_ < ((what & 4) ? 2 : 1); ++rs_)
    if (what & 2) {
        const int t = t0 + wid, n = t + 1;
        const LAS float* row = sc + wid * 4096 + lane;
        GAS unsigned long long* mout = (GAS unsigned long long*)MASK + ((size_t)b * SEQ + t) * 64;
        const int nwords = ((t | 255) >> 6) + 1;
        const int nreg = (n + 63) >> 6;
        unsigned long long myword = 0ull;
        if (n <= 256) {
            if (lane < nwords) { const int rem = n - 64 * lane; myword = rem >= 64 ? ~0ull : (rem > 0 ? ((1ull << rem) - 1ull) : 0ull); }
        } else {
            unsigned k[64];
#pragma unroll
            for (int g = 0; g < 4; ++g) {
                if (nreg > 16 * g) {
                    float v[16];
#pragma unroll
                    for (int j = 0; j < 16; ++j) v[j] = row[64 * (16 * g + j)];
#pragma unroll
                    for (int j = 0; j < 16; ++j) k[16 * g + j] = (16 * g + j < nreg) ? fkey(v[j]) : 0u;
                } else {
#pragma unroll
                    for (int j = 0; j < 16; ++j) k[16 * g + j] = 0u;
                }
            }
            unsigned T = 0u, cge = (unsigned)n;
#define CNT_BLOCK(g) do { unsigned long long mm_[16]; \
                _Pragma("unroll") for (int j = 0; j < 16; ++j) asm volatile("v_cmp_le_u32_e64 %0, %1, %2" : "=s"(mm_[j]) : "s"(cand), "v"(k[16 * (g) + j])); \
                asm volatile("s_nop 4"); __builtin_amdgcn_sched_barrier(0);        \
                _Pragma("unroll") for (int j = 0; j < 16; ++j) c += (unsigned)__builtin_popcountll(mm_[j]); \
                __builtin_amdgcn_sched_barrier(0); } while (0)
#define CNT_ALL() do { CNT_BLOCK(0); if (nreg > 16) { CNT_BLOCK(1); if (nreg > 32) { CNT_BLOCK(2); if (nreg > 48) CNT_BLOCK(3); } } } while (0)
            unsigned plo[16], phi[16];
#define IDX_TRANSPOSE(G, PL) do { unsigned w_[16]; \
                _Pragma("unroll") for (int i = 0; i < 16; ++i) w_[i] = (k[32 * (G) + i] >> 16) | (k[32 * (G) + 16 + i] & 0xffff0000u); \
                _Pragma("unroll") for (int st = 0; st < 4; ++st) { const int s_ = 8 >> st; const unsigned m_ = st == 0 ? 0x00ff00ffu : (st == 1 ? 0x0f0f0f0fu : (st == 2 ? 0x33333333u : 0x55555555u)); \
                    _Pragma("unroll") for (int i = 0; i < 16; ++i) if ((i & s_) == 0) { const unsigned t_ = ((w_[i] >> s_) ^ w_[i + s_]) & m_; w_[i + s_] ^= t_; w_[i] ^= (t_ << s_); } } \
                _Pragma("unroll") for (int b_ = 0; b_ < 16; ++b_) PL[b_] = w_[b_]; } while (0)
            IDX_TRANSPOSE(0, plo);
            if (nreg > 32) { IDX_TRANSPOSE(1, phi); } else {
#pragma unroll
                for (int b_ = 0; b_ < 16; ++b_) phi[b_] = 0u; }
#undef IDX_TRANSPOSE
            unsigned alo = 0xffffffffu, ahi = nreg > 32 ? 0xffffffffu : 0u, above = 0u, T16 = 0u;
#pragma unroll
            for (int bit = 15; bit >= 0; --bit) {
                const unsigned xlo = alo & plo[bit], xhi = ahi & phi[bit];
                const unsigned c1 = wave_sum_u32((unsigned)__builtin_popcount(xlo) + (unsigned)__builtin_popcount(xhi));
                if (above + c1 >= 256u) { T16 |= 1u << bit; alo = xlo; ahi = xhi; }
                else { above += c1; alo ^= xlo; ahi ^= xhi; }
            }
            const unsigned nC = wave_sum_u32((unsigned)__builtin_popcount(alo) + (unsigned)__builtin_popcount(ahi));
            const unsigned cnt_hi = above, need1 = 256u - cnt_hi;
            T = T16 << 16; cge = cnt_hi + nC;
            if (T16 == 0u) {
                T = 0u; cge = (unsigned)n;
#pragma unroll 1
                for (int bit = 31; bit >= 0; --bit) { const unsigned cand = T | (1u << bit); unsigned c = 0u; CNT_ALL(); if (c >= 256u) { T = cand; cge = c; } }
            } else if (nC > need1) {
                if (nC <= 64u) {
                    unsigned ck = 0u; int slot = 0;
#pragma unroll
                    for (int j = 0; j < 64; ++j) {
                        unsigned long long mk_ = __ballot((((j < 32 ? alo : ahi) >> (j & 31)) & 1u) != 0u);
                        while (mk_) { const int l_ = __builtin_ctzll(mk_); const unsigned v_ = (unsigned)__builtin_amdgcn_readlane((int)k[j], l_);
                            { unsigned keep_; asm volatile("s_mov_b32 %1, m0\n\ts_mov_b32 m0, %3\n\ts_nop 4\n\tv_writelane_b32 %0, %2, m0\n\ts_mov_b32 m0, %1" : "+v"(ck), "=&s"(keep_) : "s"(v_), "s"(slot)); }
                            ++slot; mk_ &= mk_ - 1ull; }
                    }
#pragma unroll 1
                    for (int bit = 15; bit >= 0; --bit) {
                        const unsigned cand = T | (1u << bit);
                        const unsigned c = cnt_hi + (unsigned)__popcll(__ballot(ck >= cand));
                        if (c >= 256u) { T = cand; cge = c; }
                    }
                } else {
#pragma unroll 1
                    for (int bit = 15; bit >= 0; --bit) {
                        const unsigned cand = T | (1u << bit);
                        unsigned c = 0u;
                        CNT_ALL();
                        if (c >= 256u) { T = cand; cge = c; }
                    }
                }
            }
            unsigned mlo = 0u, mhi = 0u;
            if (cge == 256u) {
                const unsigned cand = T;
#pragma unroll
                for (int g = 0; g < 4; ++g) if (16 * g < nreg) {
                    unsigned long long mm_[16];
#pragma unroll
                    for (int j = 0; j < 16; ++j) asm volatile("v_cmp_le_u32_e64 %0, %1, %2" : "=s"(mm_[j]) : "s"(cand), "v"(k[16 * g + j]));
                    __builtin_amdgcn_sched_barrier(0);
#pragma unroll
                    for (int j = 0; j < 16; ++j) { asm volatile("s_nop 1\n\tv_writelane_b32 %0, %1, %2" : "+v"(mlo) : "s"((unsigned)mm_[j]), "i"(16 * g + j)); asm volatile("v_writelane_b32 %0, %1, %2" : "+v"(mhi) : "s"((unsigned)(mm_[j] >> 32)), "i"(16 * g + j)); }
                    __builtin_amdgcn_sched_barrier(0);
                }
            } else {
                unsigned cgt = 0u;
#pragma unroll
                for (int j = 0; j < 64; ++j) cgt += (unsigned)__popcll(__ballot(k[j] > T));
                const unsigned need = 256u - cgt;
                unsigned tie_run = 0u; const unsigned long long lt = (1ull << lane) - 1ull;
#pragma unroll
                for (int j = 0; j < 64; ++j) {
                    const bool eq = (k[j] == T);
                    const unsigned long long beq = __ballot(eq);
                    const bool sel = (k[j] > T) || (eq && (tie_run + (unsigned)__popcll(beq & lt)) < need);
                    tie_run += (unsigned)__popcll(beq);
                    const unsigned long long w_ = __ballot(sel);
                    asm volatile("s_nop 4\n\tv_writelane_b32 %0, %1, %2" : "+v"(mlo) : "s"((unsigned)w_), "i"(j)); asm volatile("v_writelane_b32 %0, %1, %2" : "+v"(mhi) : "s"((unsigned)(w_ >> 32)), "i"(j));
                }
            }
            myword = ((unsigned long long)mhi << 32) | mlo;
#undef CNT_BLOCK
#undef CNT_ALL
        }
        if (lane < nwords) mout[lane] = myword;
    }
    if (has_next) idx_preload(P, QI, KI, WI, nb, nt0);
    __syncthreads();
}
#undef IDX_KLOAD


struct Args { const float* in[22]; float* out; unsigned char* ws; int ph_lo, ph_hi; };
constexpr int NPHASES = 1 + DEPTH * 12 + 1;

constexpr int CV_NIT[12] = {(DM / 64) * (NGU / 32), (DFF / 64) * (DM / 32), (DM / 64) * (NIN / 32), 6 * (DM / 32), 6 * (DM / 32), 6 * (DM / 32), (DM / 64) * (DM / 32), (DM / 64) * (512 / 32),
                            (DM / 64) * (DM / 32), (512 / 64) * (DM / 32), (DM / 64) * (NGU / 32), (DFF / 64) * (DM / 32)};
constexpr int cv_start(int i) { int s = 0; for (int j = 0; j < i; ++j) s += CV_NIT[j]; return s; }
constexpr int CV_TOTAL = cv_start(12);
template <int THROTTLE = 0>
__device__ __forceinline__ void conv_layer(const Args& a, int l, LAS float* scr, int gw, int NGW, int lane) {
    const size_t L = (size_t)l;
    for (int g = gw; g < CV_TOTAL; g += NGW) {
        if (THROTTLE > 0 && g != gw) __builtin_amdgcn_s_sleep(THROTTLE);
        ConvMat cm; size_t off; const float* W0; const float* G0 = nullptr; int it;
#define CVCASE(i, wi, GSET, OFF, KS, NS, KD, ND, MP) if (g < cv_start(i + 1)) { it = g - cv_start(i); W0 = a.in[wi]; asm volatile("" : "+s"(W0)); GSET; off = (OFF); cm.Ksrc = (KS); cm.Nsrc = (NS); cm.Kdst = (KD); cm.Ndst = (ND); cm.map = (MP); }
        CVCASE(0, 4, { G0 = a.in[3]; asm volatile("" : "+s"(G0)); }, W_GU1, DM, NGU, DM, NGU, 1)
        else CVCASE(1, 5, {}, W_DN1, DFF, DM, DFF, DM, 0)
        else CVCASE(2, 7, { G0 = a.in[6]; asm volatile("" : "+s"(G0)); }, W_IN, DM, DIN, DM, NIN, 2)
        else CVCASE(3, 9, {}, W_BR, 384, DM, 384, DM, 0)
        else CVCASE(4, 10, {}, W_BR + (size_t)DM * 384 * 2, 320, DM, 384, DM, 0)
        else CVCASE(5, 11, {}, W_BR + (size_t)2 * DM * 384 * 2, 320, DM, 384, DM, 0)
        else CVCASE(6, 12, {}, W_OUT, DM, DM, DM, DM, 0)
        else CVCASE(7, 15, { G0 = a.in[13]; asm volatile("" : "+s"(G0)); }, W_CQ, DM, 512, DM, 512, 0)
        else CVCASE(8, 16, { G0 = a.in[14]; asm volatile("" : "+s"(G0)); }, W_CKV, DM, DM, DM, DM, 0)
        else CVCASE(9, 17, {}, W_CO, 512, DM, 512, DM, 0)
        else CVCASE(10, 19, { G0 = a.in[18]; asm volatile("" : "+s"(G0)); }, W_GU2, DM, NGU, DM, NGU, 1)
        else CVCASE(11, 20, {}, W_DN2, DFF, DM, DFF, DM, 0)
        else break;
#undef CVCASE
        cm.W = W0 + L * ((size_t)cm.Ksrc * cm.Nsrc); cm.gain = G0 ? G0 + L * DM : (const float*)nullptr; cm.WT = (bf16*)(a.ws + ((l & 1) ? WS_W2 : WS_W) + off);
        const int nblk = cm.Ndst / 32, kb = it / nblk, nb = it % nblk;
        if (cm.map == 0) conv_item<0>(cm.W, cm.Ksrc, cm.Nsrc, cm.WT, cm.Kdst, cm.gain, scr, kb, nb, lane);
        else if (cm.map == 1) conv_item<1>(cm.W, cm.Ksrc, cm.Nsrc, cm.WT, cm.Kdst, cm.gain, scr, kb, nb, lane);
        else conv_item<2>(cm.W, cm.Ksrc, cm.Nsrc, cm.WT, cm.Kdst, cm.gain, scr, kb, nb, lane);
    }
}

constexpr int MIX_NLV = 48, MIX_NUNITS = 1024, MIX_NCONV = 512;
#ifndef MIX_ORDER
#define MIX_ORDER 1
#endif
#if MIX_ORDER == 2
__constant__ const unsigned char MIX_LV_TYPE[48] = {1,1,1,0,1,0,1,0,1,0,0,1,0,1,0,1,0,1,0,1,0,0,1,0,1,2,2,2,2,2,2,2,2,2,2,2,2,2,2,2,2,0,1,0,1,0,1,0};
__constant__ const unsigned char MIX_LV_QB[48] = {15,14,13,15,12,14,11,13,10,12,11,9,10,8,9,7,8,6,7,5,6,5,4,4,3,15,14,13,12,11,10,9,8,7,6,5,4,3,2,1,0,3,2,2,1,1,0,0};
__constant__ const unsigned short MIX_LV_START[49] = {0,20,40,60,84,104,128,148,172,192,216,240,260,284,304,328,348,372,392,416,436,460,484,504,528,548,568,588,608,628,648,668,688,708,728,748,768,788,808,828,848,868,892,912,936,956,980,1000,1024};
#elif MIX_ORDER == 0
__constant__ const unsigned char MIX_LV_TYPE[48] = {1,1,1,1,1,1,1,1,0,1,0,0,0,0,1,0,0,0,0,1,0,0,1,0,1,0,1,0,1,0,2,2,2,2,2,2,2,2,2,2,2,2,2,2,2,2,1,0};
__constant__ const unsigned char MIX_LV_QB[48] = {15,14,13,12,11,10,9,8,15,7,14,13,12,11,6,10,9,8,7,5,6,5,4,4,3,3,2,2,1,1,15,14,13,12,11,10,9,8,7,6,5,4,3,2,1,0,0,0};
__constant__ const unsigned short MIX_LV_START[49] = {0,20,40,60,80,100,120,140,160,184,204,228,252,276,300,320,344,368,392,416,436,460,484,504,528,548,572,592,616,636,660,680,700,720,740,760,780,800,820,840,860,880,900,920,940,960,980,1000,1024};
#else
__constant__ const unsigned char MIX_LV_TYPE[48] = {1,0,1,0,1,0,1,0,1,0,1,0,1,0,1,0,1,0,1,0,1,0,1,0,2,2,2,2,2,2,2,2,2,2,2,2,2,2,2,2,1,0,1,0,1,0,1,0};
__constant__ const unsigned char MIX_LV_QB[48] = {15,15,14,14,13,13,12,12,11,11,10,10,9,9,8,8,7,7,6,6,5,5,4,4,15,14,13,12,11,10,9,8,7,6,5,4,3,2,1,0,3,3,2,2,1,1,0,0};
__constant__ const unsigned short MIX_LV_START[49] = {0,20,44,64,88,108,132,152,176,196,220,240,264,284,308,328,352,372,396,416,440,460,484,504,528,548,568,588,608,628,648,668,688,708,728,748,768,788,808,828,848,868,892,912,936,956,980,1000,1024};
#endif

#define WSO unsigned char* ws = a.ws; asm volatile("" : "+s"(ws)); float* x = a.out
#define xb ((bf16*)(ws + WS_XB))
#define ssq ((float*)(ws + WS_SSQ))
#define cosT ((float*)(ws + WS_COS))
#define sinT ((float*)(ws + WS_SIN))
#define memb ((bf16*)(ws + WS_MEMB))
#define memssq ((float*)(ws + WS_MEMSSQ))
#define lfb ((float*)(ws + WS_LF))
#define widx ((float*)(ws + WS_WIDX))
#define mk ((bf16*)(ws + WS_MK))
#define mvt ((bf16*)(ws + WS_MVT))
#define wl (ws + ((l & 1) ? WS_W2 : WS_W))
#define act ((bf16*)(ws + WS_ACT))
#define qkn ((bf16*)(ws + WS_QKN))
#define qkr ((bf16*)(ws + WS_QKR))
#define vt ((bf16*)(ws + WS_VT))
#define gates ((bf16*)(ws + WS_GATES))
#define maskb ((unsigned long long*)(ws + WS_MASK))
#define oatt ((bf16*)(ws + WS_OATT))
#define mf ((float*)(ws + WS_MF))
#define mb ((bf16*)(ws + WS_MB))
#define caq ((bf16*)(ws + WS_CAQ))
#define cao ((bf16*)(ws + WS_CAO))
__global__ void __launch_bounds__(NTHREADS, 2) mk_fwd(Args a) {
    extern __shared__ __attribute__((aligned(16))) unsigned char lds_raw[];
    LAS unsigned char* lds = (LAS unsigned char*)lds_raw;
    constexpr int G = 256, NGW = G * NWAVES; const int bx = blockIdx.x;
    if (threadIdx.x < 32) ((volatile LAS unsigned*)(lds + MISC_OFF))[threadIdx.x] = 0u;
    __syncthreads();
    (void)xcd_barrier_post((unsigned*)(a.ws + WS_CTL) + CW_BAR, (volatile LAS unsigned*)(lds + MISC_OFF) + 8);
#define TIDS int tid = threadIdx.x; asm volatile("" : "+v"(tid)); const int lane = tid & 63, wave = __builtin_amdgcn_readfirstlane(tid >> 6), gw = bx * NWAVES + wave; (void)lane; (void)gw

#if MK_PER_PHASE
    const int lo = a.ph_lo, hi_ph = a.ph_hi;
    int pid = 0;
#define PH_ON (lo <= pid && pid < hi_ph)
#else
#define PH_ON true
#endif
#ifndef TEST_SITE
#define TEST_SITE (-1)
#endif
#define SITE(k) (TEST_SITE < 0 || TEST_SITE == (k))
#ifndef PROBE_DUP
#define PROBE_DUP (-1)
#endif
#ifndef PROBE_REPS
#define PROBE_REPS 2
#endif
#define NREP(k) ((PROBE_DUP == (k)) ? PROBE_REPS : 1)
#ifndef CONV_REPEAT
#define CONV_REPEAT 1
#endif
#ifndef CONV_THROTTLE
#define CONV_THROTTLE 0
#endif
#ifndef FUSE_FINAL
#define FUSE_FINAL 0
#endif
#ifndef QUEUE_AHEAD
#define QUEUE_AHEAD 0
#endif
#ifndef GEMM_ALIGN
#define GEMM_ALIGN true
#endif
#ifndef GEMM_SP2
#define GEMM_SP2 true
#endif
#ifndef CONV_FIRST
#define CONV_FIRST 0
#endif
#ifndef PROBE_DNK
#define PROBE_DNK(r) DFF
#endif
#ifndef PROBE_GUK
#define PROBE_GUK(r) DM
#endif
#if MK_PER_PHASE
#define PH_END do { ++pid; } while (0)
#else
#define PH_END do { { XcdBarrier bar_; bar_.bar = (unsigned*)(a.ws + WS_CTL) + CW_BAR; bar_.x = xb_xcc_id(); bar_.st = (volatile LAS unsigned*)(lds + MISC_OFF) + 8; xcd_barrier(bar_); } } while (0)
#endif
#define GEMM(EpiT, E, Aptr, Bptr, Mv, Nv, Kv, cid) do { pg8::Gemm g_{(const pg8::bf16_t*)(Aptr), (const pg8::bf16_t*)(Bptr), (Mv), (Nv), (Kv)}; pg8::StaticOrder S_; S_.init((Mv), (Nv), G, (cid)); \
        pg8::gemm_phase<EpiT, pg8::StaticOrder, GEMM_ALIGN, GEMM_SP2>(lds, g_, S_, E); } while (0)

    if (PH_ON && SITE(0)) for (int rep_ = 0; rep_ < NREP(0); ++rep_) { WSO; TIDS;
        const float* xin = a.in[0];
        for (int mrow = gw; mrow < MTOK; mrow += 4 * NGW) {
            f32x4 v[4][4];
#pragma unroll
            for (int rr = 0; rr < 4; ++rr)
#pragma unroll
                for (int j = 0; j < 4; ++j) v[rr][j] = ((const GAS f32x4*)(xin + (size_t)(mrow + rr * NGW) * DM) + lane)[64 * j];
#pragma unroll
            for (int rr = 0; rr < 4; ++rr) {
                GAS u32x2* xbo = (GAS u32x2*)(xb + (size_t)(mrow + rr * NGW) * DM) + lane; float s = 0.f;
#pragma unroll
                for (int j = 0; j < 4; ++j) { const f32x4 w = v[rr][j]; s += (w.x * w.x + w.y * w.y) + (w.z * w.z + w.w * w.w); xbo[64 * j] = (u32x2){pk2(w.x, w.y), pk2(w.z, w.w)}; }
                s = wave_sum(s);
                if (lane < 4) *(GAS float*)(ssq + (size_t)(mrow + rr * NGW) * 4 + lane) = (lane == 0) ? s : 0.f;
            }
        }
        const float* memin = a.in[1];
        for (int mrow = gw; mrow < MROWS; mrow += NGW) {
            const GAS f32x4* xr = (const GAS f32x4*)(memin + (size_t)mrow * DM) + lane; GAS u32x2* xbo = (GAS u32x2*)(memb + (size_t)mrow * DM) + lane; float s = 0.f;
#pragma unroll
            for (int j = 0; j < 4; ++j) { const f32x4 v = xr[64 * j]; s += (v.x * v.x + v.y * v.y) + (v.z * v.z + v.w * v.w); xbo[64 * j] = (u32x2){pk2(v.x, v.y), pk2(v.z, v.w)}; }
            s = wave_sum(s);
            if (lane == 0) memssq[mrow] = s;
        }
        const int* pos = (const int*)a.in[2];
        for (int idx = bx * NTHREADS + tid; idx < MTOK * 32; idx += G * NTHREADS) {
            const int row = idx >> 5, i = idx & 31;
            double f = 1.0; for (int k = 0; k < i; ++k) f *= 0.74989420933245582730;
            const float ang = (float)pos[row] * (float)f;
            const double ad = (double)ang; const double kk = __builtin_rint(ad * 0.15915494309189533577); const float red = (float)(ad - kk * 6.283185307179586476925);
            *(GAS unsigned*)((unsigned*)cosT + idx) = pk2(__builtin_amdgcn_cosf(red * 0.15915494309189535f), __builtin_amdgcn_sinf(red * 0.15915494309189535f));
        }
        conv_layer(a, 0, (LAS float*)(lds + wave * 16384), gw, NGW, lane);
#if defined(PROBE_CONV0)
        for (int pc_ = 0; pc_ < PROBE_CONV0; ++pc_) conv_layer(a, 0, (LAS float*)(lds + wave * 16384), gw, NGW, lane);
#endif
    }
    PH_END;

#define CONV_SLOTS (432 * NWAVES)
#define CONV_FILL(first_wg, slot0) do { if (l + 1 < DEPTH && bx >= (first_wg)) { TIDS; for (int cr_ = 0; cr_ < CONV_REPEAT; ++cr_) conv_layer<CONV_THROTTLE>(a, l + 1, (LAS float*)(lds + wave * 16384), (slot0) + (bx - (first_wg)) * NWAVES + wave, CONV_SLOTS, lane); } if (PROBE_DUP >= 0) __syncthreads(); } while (0)
    for (int hs = 0; hs < 2 * DEPTH; ++hs) {
        const int l = hs >> 1, second = hs & 1;
        if (PH_ON && SITE(2)) for (int rep_ = 0; rep_ < NREP(2); ++rep_) { WSO;
#if defined(PROBE_EPITRIV)
            EpiGU E{act, ssq, rep_ == 0 ? 1 : 0};
#else
            EpiGU E{act, ssq};
#endif
#if CONV_FIRST
            CONV_FILL(128, second ? 304 * NWAVES : 0); if (l + 1 < DEPTH && bx >= 128) __syncthreads();
            GEMM(EpiGU, E, xb, wl + (second ? W_GU2 : W_GU1), MTOK, NGU, PROBE_GUK(rep_), bx); }
#else
            GEMM(EpiGU, E, xb, wl + (second ? W_GU2 : W_GU1), MTOK, NGU, PROBE_GUK(rep_), bx); CONV_FILL(128, second ? 304 * NWAVES : 0); }
#endif
        PH_END;
#if FUSE_FINAL
        if (hs == 2 * DEPTH - 1) {
            if (PH_ON && SITE(3)) { WSO; EpiFIN E{ws, x, a.in[21]}; GEMM(EpiFIN, E, act, wl + W_DN2, MTOK, DM, DFF, bx); }
            break;
        }
#endif
        if (PH_ON && SITE(3)) for (int rep_ = 0; rep_ < NREP(3); ++rep_) { WSO; EpiRES E{xb, ssq, rep_ ? 0.f : 0.5f, (LAS float*)(lds + LDS_HIST)}; GEMM(EpiRES, E, act, wl + (second ? W_DN2 : W_DN1), MTOK, DM, PROBE_DNK(rep_), bx); }
        PH_END;
        if (second) continue;

        if (PH_ON && SITE(4)) for (int rep_ = 0; rep_ < NREP(4); ++rep_) { WSO; EpiIN E{qkn, qkr, vt, gates, lfb, widx, ssq, cosT, sinT, a.in[8] + l * 6, (unsigned*)(a.ws + WS_CTL) + CW_KINF + l * 32
#if defined(PROBE_NOV)
            , (rep_ + 1 < NREP(4)) ? 1 : 0
#endif
            }; GEMM(EpiIN, E, xb, wl + W_IN, MTOK, NIN, DM, bx); CONV_FILL(192, 128 * NWAVES); }
        PH_END;
        if (PH_ON && SITE(5)) for (int rep_ = 0; rep_ < NREP(5); ++rep_) { WSO; TIDS;
            constexpr int NIDX = MTOK / 8;
            const bf16* QI_ = qkr + (size_t)10 * MTOK * 64; const bf16* KI_ = qkr + (size_t)18 * MTOK * 64;
#define IDX_AT(r_, b_, t_) do { const int c_ = ((r_) & 1) ? (G - 1 - bx) : bx; const int pi_ = (r_) * G + c_; b_ = pi_ % 4; t_ = 8 * ((NIDX / 4 - 1) - pi_ / 4); } while (0)
            IdxPre P_;
            { int b0_, t0_; IDX_AT(0, b0_, t0_); idx_preload(P_, QI_, KI_, widx, b0_, t0_); }
            for (int r = 0; r < NIDX / G; ++r) {
                int b, t0, nb, nt0; IDX_AT(r, b, t0); IDX_AT(r + 1, nb, nt0);
#if defined(PROBE_IDX)
                idx_unit(lds, P_, QI_, KI_, widx, maskb, b, t0, r + 1 < NIDX / G, nb, nt0, rep_ == 0 ? 3 : PROBE_IDX);
#else
                idx_unit(lds, P_, QI_, KI_, widx, maskb, b, t0, r + 1 < NIDX / G, nb, nt0);
#endif
            }
#undef IDX_AT
        }
        PH_END;
        if (PH_ON && SITE(6)) for (int rep_ = 0; rep_ < NREP(6); ++rep_) { WSO; TIDS;
            volatile LAS int* qslot = (volatile LAS int*)(lds + MISC_OFF) + 16;
            unsigned* qhead = (unsigned*)(a.ws + WS_CTL) + CW_QUEUE + 64 * (4 * l + rep_);
            const int ntot = MIX_NUNITS;
            unsigned nxt_ = 0u;
            if (QUEUE_AHEAD && tid == 0) nxt_ = __hip_atomic_fetch_add(qhead, 1u, RLX_AGENT);
            for (;;) {
                if (!QUEUE_AHEAD && tid == 0) nxt_ = __hip_atomic_fetch_add(qhead, 1u, RLX_AGENT);
                if (tid == 0) qslot[0] = (int)nxt_;
                __syncthreads();
                const int p = qslot[0];
                __syncthreads();
                if (p >= ntot) break;
                if (QUEUE_AHEAD && tid == 0) nxt_ = __hip_atomic_fetch_add(qhead, 1u, RLX_AGENT);
                int lv = 0;
                while (p >= (int)MIX_LV_START[lv + 1]) ++lv;
                const int type = MIX_LV_TYPE[lv], qb = MIX_LV_QB[lv], j = p - (int)MIX_LV_START[lv];
#if defined(MIX_ONLY)
                if (type != MIX_ONLY) continue;
#endif
#if defined(PROBE_TYPE)
                if (rep_ == 1 && type != PROBE_TYPE) continue;
#endif
                if (type == 0) {
                    const int b = j / 6, h = j % 6;
                    LAS float* cl2 = (LAS float*)(lds + 65536);
                    {
                        int tid = threadIdx.x; asm volatile("" : "+v"(tid)); const int lane = tid & 63, wave = __builtin_amdgcn_readfirstlane(tid >> 6);
                        const GAS f32x4* src = (const GAS f32x4*)(lfb + (size_t)h * MTOK + (size_t)b * SEQ + 8 * tid);
                        const f32x4 v0 = src[0], v1 = src[1];
                        float e[8]; e[0] = v0.x; e[1] = e[0] + v0.y; e[2] = e[1] + v0.z; e[3] = e[2] + v0.w; e[4] = e[3] + v1.x; e[5] = e[4] + v1.y; e[6] = e[5] + v1.z; e[7] = e[6] + v1.w;
                        float inc = e[7];
#pragma unroll
                        for (int o = 1; o < 64; o <<= 1) { const float v = __shfl_up(inc, o); if (lane >= o) inc += v; }
                        LAS float* wsum = (LAS float*)(lds + 65536 + 16384);
                        if (lane == 63) wsum[wave] = inc;
                        __syncthreads();
                        float off = inc - e[7];
                        for (int w = 0; w < wave; ++w) off += wsum[w];
#pragma unroll
                        for (int jj = 0; jj < 8; ++jj) cl2[8 * tid + jj] = -(off + e[jj]) * LOG2E;
                        __syncthreads();
                    }
                    const size_t hb = (size_t)b * SEQ * 64;
                    flash_unit<64, 0>(lds, qkn + (size_t)h * MTOK * 64 + hb, qkn + (size_t)(6 + h) * MTOK * 64 + hb, vt + (size_t)(h * 4 + b) * 64 * SEQ, SEQ,
                                      oatt + (size_t)b * SEQ * 384 + h * 64, 384, qb * 256, 4 * (qb + 1), nullptr, cl2,
                                      __uint_as_float(__hip_atomic_load((unsigned*)(a.ws + WS_CTL) + CW_KINF + l * 32 + b * 8 + h, RLX_AGENT)));
                } else {
                    const int b = j / 5, h = j % 5;
                    const size_t hb = (size_t)b * SEQ * 64;
                    if (type == 1) {
                        flash_unit<64, 1>(lds, qkr + (size_t)h * MTOK * 64 + hb, qkr + (size_t)(5 + h) * MTOK * 64 + hb, vt + (size_t)((6 + h) * 4 + b) * 64 * SEQ, SEQ,
                                          oatt + (size_t)MTOK * 384 + (size_t)b * SEQ * 384 + h * 64, 384, qb * 256, 4 * (qb + 1), maskb + (size_t)b * SEQ * 64, nullptr);
                    } else {
                        sb_unit(lds, qkn + (size_t)(12 + h) * MTOK * 64 + hb, qkn + (size_t)(17 + h) * MTOK * 64 + hb, vt + (size_t)((11 + h) * 4 + b) * 64 * SEQ,
                                oatt + (size_t)2 * MTOK * 384 + (size_t)b * SEQ * 384 + h * 64, qb * 256);
                    }
                    if (h == 4) {
                        int t2 = threadIdx.x; asm volatile("" : "+v"(t2));
                        bf16* ob = oatt + (size_t)type * MTOK * 384 + ((size_t)b * SEQ + qb * 256 + (t2 >> 1)) * 384 + 320 + 32 * (t2 & 1);
#pragma unroll
                        for (int jj = 0; jj < 4; ++jj) *(GAS u32x4*)(ob + 8 * jj) = (u32x4){0u, 0u, 0u, 0u};
                    }
                }
            }
        }
        PH_END;
        if (PH_ON && SITE(7)) for (int rep_ = 0; rep_ < NREP(7); ++rep_) { WSO;
            EpiBR E{gates, mf, mb}; pg8::Gemm g_{(const pg8::bf16_t*)oatt, (const pg8::bf16_t*)(wl + W_BR), 3 * MTOK, 3 * DM, 384}; BranchOrder S_; S_.S.init(MTOK, DM, G, bx);
            pg8::gemm_phase<EpiBR, BranchOrder, GEMM_ALIGN, GEMM_SP2>(lds, g_, S_, E);
        }
        PH_END;
        if (PH_ON && SITE(8)) for (int rep_ = 0; rep_ < NREP(8); ++rep_) { WSO; EpiRES E{xb, ssq, rep_ ? 0.f : 1.0f, (LAS float*)(lds + LDS_HIST)}; GEMM(EpiRES, E, mb, wl + W_OUT, MTOK, DM, DM, bx); }
        PH_END;
        if (PH_ON && SITE(9)) for (int rep_ = 0; rep_ < NREP(9); ++rep_) { WSO;
            { EpiCQ E{caq, ssq}; GEMM(EpiCQ, E, xb, wl + W_CQ, MTOK, 512, DM, bx); }
            { EpiCKV E{mk, mvt, memssq}; GEMM(EpiCKV, E, memb, wl + W_CKV, MROWS, DM, DM, (bx + G - 128) % G); }
            CONV_FILL(144, 192 * NWAVES);
        }
        PH_END;
        if (PH_ON && SITE(10)) for (int rep_ = 0; rep_ < NREP(10); ++rep_) { WSO;
            for (int p = bx; p < 256; p += G) {
                const int b = p >> 6, h = (p >> 4) & 3, qb = p & 15;
                flash_unit<128, 2>(lds, caq + ((size_t)h * MTOK + (size_t)b * SEQ) * 128, mk + (size_t)(b * 4 + h) * 256 * 128, mvt + (size_t)(b * 4 + h) * 128 * 256, 256,
                                   cao + (size_t)b * SEQ * 512 + h * 128, 512, qb * 256, 4, nullptr, nullptr);
            }
        }
        PH_END;
#if defined(PROBE_BAR)
        for (int eb_ = 0; eb_ < PROBE_BAR; ++eb_) PH_END;
#endif
        if (PH_ON && SITE(11)) for (int rep_ = 0; rep_ < NREP(11); ++rep_) { WSO; EpiRES E{xb, ssq, rep_ ? 0.f : 1.0f, (LAS float*)(lds + LDS_HIST)}; GEMM(EpiRES, E, cao, wl + W_CO, MTOK, DM, 512, bx); }
        PH_END;
    }
    if (!FUSE_FINAL && PH_ON && SITE(12)) for (int rep_ = 0; rep_ < NREP(12); ++rep_) { WSO; TIDS;
        const float* gfin = a.in[21];
        f32x4 gv[4];
#pragma unroll
        for (int j = 0; j < 4; ++j) gv[j] = ((const GAS f32x4*)gfin)[lane + 64 * j];
        for (int mrow = gw; mrow < MTOK; mrow += NGW) {
            const float r = rstd16(ssq, mrow);
            const GAS u32x2* xi = (const GAS u32x2*)(xb + (size_t)mrow * DM) + lane;
            GAS f32x4* xo = (GAS f32x4*)(x + (size_t)mrow * DM) + lane;
#pragma unroll
            for (int j = 0; j < 4; ++j) { const u32x2 w = xi[64 * j]; f32x4 v = {__uint_as_float(w.x << 16), __uint_as_float(w.x & 0xffff0000u), __uint_as_float(w.y << 16), __uint_as_float(w.y & 0xffff0000u)}; v = v * r * gv[j]; xo[64 * j] = v; }
        }
    }
#undef PH_ON
#undef PH_END
#undef GEMM
}

extern "C" void kernel_launch(void* const* d_in, const int* in_sizes, int n_in, void* d_out, int out_size, void* d_ws, size_t ws_size, hipStream_t stream) {
    static int grid = 0;
    if (grid == 0) {
        if (n_in != 22 || out_size != MTOK * DM || ws_size < WS_END) { fprintf(stderr, "kernel_launch: unexpected shapes (n_in %d, out %d, ws %zu < %zu); nothing launched\n", n_in, out_size, ws_size, (size_t)WS_END); grid = -1; return; }
        int dev = 0, cus = 0, per_cu = 0;
        if (hipGetDevice(&dev) != hipSuccess || hipDeviceGetAttribute(&cus, hipDeviceAttributeMultiprocessorCount, dev) != hipSuccess) { grid = -1; return; }
        if (hipFuncSetAttribute((const void*)mk_fwd, hipFuncAttributeMaxDynamicSharedMemorySize, LDS_BYTES) != hipSuccess) { fprintf(stderr, "kernel_launch: hipFuncSetAttribute failed\n"); grid = -1; return; }
        if (hipOccupancyMaxActiveBlocksPerMultiprocessor(&per_cu, (const void*)mk_fwd, NTHREADS, LDS_BYTES) != hipSuccess || per_cu < 1) { fprintf(stderr, "kernel_launch: occupancy query reports %d\n", per_cu); }
        (void)hipGetLastError();
        if (cus < 256) { fprintf(stderr, "kernel_launch: %d CUs < 256; nothing launched\n", cus); grid = -1; return; }
        grid = 256;
    }
    if (grid < 0) return;
    (void)in_sizes;
    if (hipMemsetAsync((char*)d_ws + WS_CTL, 0, CTL_ZERO_BYTES, stream) != hipSuccess) return;
    Args a{};
    for (int i = 0; i < 22; ++i) a.in[i] = (const float*)d_in[i];
    a.out = (float*)d_out; a.ws = (unsigned char*)d_ws;
#if MK_PER_PHASE
    for (int p = 0; p < NPHASES; ++p) { a.ph_lo = p; a.ph_hi = p + 1; hipLaunchKernelGGL(mk_fwd, dim3(grid), dim3(NTHREADS), LDS_BYTES, stream, a); }
#else
    a.ph_lo = 0; a.ph_hi = NPHASES;
    hipLaunchKernelGGL(mk_fwd, dim3(grid), dim3(NTHREADS), LDS_BYTES, stream, a);
#endif
}
```
